# Optimizing an MI355X kernel written in HIP

```python
import jax, jax.numpy as jnp
from jax import lax
import numpy as np

D_MODEL = 1024
BATCH = 8
SEQ = 2048
DEPTH = 4

GRID_W = 64
CTX_LEN = 256
HEAD_DIM = 64
MIX_HALF = D_MODEL // 2
N_Q_HEADS = MIX_HALF // HEAD_DIM
KV_GROUP = 4
N_KV_HEADS = N_Q_HEADS // KV_GROUP
WINDOW = 128
ATTN_BLOCK = 128
AX_DIM = HEAD_DIM // 2
ROPE_BASE = 10000.0
POOL_WIDTH = MIX_HALF
POOL_WINDOWS = (2, 4, 8, 16)
N_POOL_GROUPS = len(POOL_WINDOWS)
POOL_GROUP = POOL_WIDTH // N_POOL_GROUPS
CONV_WIDTH = 31
MLP_HIDDEN = 4 * D_MODEL
Q_WIDTH = N_Q_HEADS * HEAD_DIM
KV_WIDTH = N_KV_HEADS * HEAD_DIM
IN_WIDTH = POOL_WIDTH + Q_WIDTH + 2 * KV_WIDTH
N_EVEN = (DEPTH + 1) // 2
N_ODD = DEPTH // 2
NORM_EPS = 1e-6
NEG_LOGIT = -1e30

kernel_name = 'hybrid_pool_swa_conformer_dit'


def rms_norm(z, g):
    zf = z.astype(jnp.float32)
    zf = zf * lax.rsqrt(jnp.mean(zf * zf, axis=-1, keepdims=True) + NORM_EPS)
    return (zf * g.astype(jnp.float32)).astype(z.dtype)


def modulate(z, shift, scale):
    return z * (1 + scale) + shift


def rope_angles(S):
    rows = S // GRID_W
    row = jnp.broadcast_to(jnp.arange(rows, dtype=jnp.int32)[:, None], (rows, GRID_W)).reshape(S)
    col = jnp.broadcast_to(jnp.arange(GRID_W, dtype=jnp.int32)[None, :], (rows, GRID_W)).reshape(S)
    inv = ROPE_BASE ** (-jnp.arange(0, AX_DIM, 2, dtype=jnp.float32) / AX_DIM)
    return row.astype(jnp.float32)[:, None] * inv, col.astype(jnp.float32)[:, None] * inv


def rotate_axis(z, ang):
    cos = jnp.cos(ang)[:, None, :]
    sin = jnp.sin(ang)[:, None, :]
    z1, z2 = jnp.split(z, 2, axis=-1)
    return jnp.concatenate([z1 * cos - z2 * sin, z2 * cos + z1 * sin], axis=-1)


def axial_rope(z, ang_r, ang_c):
    zf = z.astype(jnp.float32)
    out = jnp.concatenate([rotate_axis(zf[..., :AX_DIM], ang_r), rotate_axis(zf[..., AX_DIM:], ang_c)], axis=-1)
    return out.astype(z.dtype)


def multiscale_pool(u, pool_w, pool_scale):
    B, S, _ = u.shape
    ug = u.astype(jnp.float32).reshape(B, S, N_POOL_GROUPS, POOL_GROUP)
    cs = jnp.concatenate([jnp.zeros((B, 1, N_POOL_GROUPS, POOL_GROUP), jnp.float32),
                          jnp.cumsum(ug, axis=1)], axis=1)
    t = jnp.arange(S)
    means = []
    for g, w in enumerate(POOL_WINDOWS):
        lo = jnp.clip(t - w // 2, 0, S)
        hi = jnp.clip(t + w - w // 2, 0, S)
        cnt = (hi - lo).astype(jnp.float32)[None, :, None]
        csg = cs[:, :, g]
        means.append((jnp.take(csg, hi, axis=1) - jnp.take(csg, lo, axis=1)) / cnt)
    pooled = jnp.stack(means, axis=2)
    d = (pooled - ug).astype(u.dtype)
    y = jnp.einsum('bsgc,gcd->bsgd', d, pool_w).reshape(B, S, POOL_WIDTH)
    return y * pool_scale


def window_attention(q, k, v, kc, vc, sink):
    B, S = q.shape[0], q.shape[1]
    L = kc.shape[1]
    nb = S // ATTN_BLOCK
    scale = HEAD_DIM ** -0.5
    qb = q.reshape(B, nb, ATTN_BLOCK, N_KV_HEADS, KV_GROUP, HEAD_DIM)
    pad = ((0, 0), (ATTN_BLOCK, ATTN_BLOCK), (0, 0), (0, 0))
    kp = jnp.pad(k, pad).reshape(B, nb + 2, ATTN_BLOCK, N_KV_HEADS, HEAD_DIM)
    vp = jnp.pad(v, pad).reshape(B, nb + 2, ATTN_BLOCK, N_KV_HEADS, HEAD_DIM)
    kw = jnp.concatenate([kp[:, :-2], kp[:, 1:-1], kp[:, 2:]], axis=2)
    vw = jnp.concatenate([vp[:, :-2], vp[:, 1:-1], vp[:, 2:]], axis=2)
    s_band = jnp.einsum('bnqkgd,bnjkd->bnkgqj', qb, kw).astype(jnp.float32) * scale
    qpos = (jnp.arange(nb) * ATTN_BLOCK)[:, None, None] + jnp.arange(ATTN_BLOCK)[None, :, None]
    kpos = (jnp.arange(nb) * ATTN_BLOCK - ATTN_BLOCK)[:, None, None] + jnp.arange(3 * ATTN_BLOCK)[None, None, :]
    valid = (jnp.abs(kpos - qpos) <= WINDOW) & (kpos >= 0) & (kpos < S)
    s_band = jnp.where(valid[None, :, None, None], s_band, NEG_LOGIT)
    s_ctx = jnp.einsum('bnqkgd,blkd->bnkgql', qb, kc).astype(jnp.float32) * scale
    s_sink = jnp.broadcast_to(sink.astype(jnp.float32).reshape(1, 1, N_KV_HEADS, KV_GROUP, 1, 1),
                              s_ctx.shape[:-1] + (1,))
    p = jax.nn.softmax(jnp.concatenate([s_sink, s_ctx, s_band], axis=-1), axis=-1)
    p_ctx = p[..., 1:1 + L].astype(v.dtype)
    p_band = p[..., 1 + L:].astype(v.dtype)
    out = (jnp.einsum('bnkgql,blkd->bnqkgd', p_ctx, vc)
           + jnp.einsum('bnkgqj,bnjkd->bnqkgd', p_band, vw))
    return out.reshape(B, S, Q_WIDTH)


def context_attention(qc, kc, vc, sink):
    B, L = qc.shape[0], qc.shape[1]
    qg = qc.reshape(B, L, N_KV_HEADS, KV_GROUP, HEAD_DIM)
    s = jnp.einsum('blkgd,bmkd->bkglm', qg, kc).astype(jnp.float32) * (HEAD_DIM ** -0.5)
    s_sink = jnp.broadcast_to(sink.astype(jnp.float32).reshape(1, N_KV_HEADS, KV_GROUP, 1, 1), s.shape[:-1] + (1,))
    p = jax.nn.softmax(jnp.concatenate([s_sink, s], axis=-1), axis=-1)[..., 1:].astype(vc.dtype)
    return jnp.einsum('bkglm,bmkd->blkgd', p, vc).reshape(B, L, Q_WIDTH)


def even_mixer(hx, hc, w_in, pool_w, pool_scale, sink, w_out, ang_r, ang_c, ctx_out):
    B, S, _ = hx.shape
    L = hc.shape[1]
    px = hx @ w_in
    u = px[..., :POOL_WIDTH]
    q = px[..., POOL_WIDTH:POOL_WIDTH + Q_WIDTH].reshape(B, S, N_Q_HEADS, HEAD_DIM)
    k = px[..., POOL_WIDTH + Q_WIDTH:POOL_WIDTH + Q_WIDTH + KV_WIDTH].reshape(B, S, N_KV_HEADS, HEAD_DIM)
    v = px[..., POOL_WIDTH + Q_WIDTH + KV_WIDTH:].reshape(B, S, N_KV_HEADS, HEAD_DIM)
    q = axial_rope(q, ang_r, ang_c)
    k = axial_rope(k, ang_r, ang_c)
    pkv = hc @ w_in[:, POOL_WIDTH + Q_WIDTH:]
    kc = pkv[..., :KV_WIDTH].reshape(B, L, N_KV_HEADS, HEAD_DIM)
    vc = pkv[..., KV_WIDTH:].reshape(B, L, N_KV_HEADS, HEAD_DIM)
    y_pool = multiscale_pool(u, pool_w, pool_scale)
    y_attn = window_attention(q, k, v, kc, vc, sink)
    out_x = jnp.concatenate([y_pool, y_attn], axis=-1) @ w_out
    if not ctx_out:
        return out_x, None
    pc = hc @ w_in[:, :POOL_WIDTH + Q_WIDTH]
    uc = pc[..., :POOL_WIDTH]
    qc = pc[..., POOL_WIDTH:].reshape(B, L, N_Q_HEADS, HEAD_DIM)
    yc = jnp.concatenate([multiscale_pool(uc, pool_w, pool_scale), context_attention(qc, kc, vc, sink)], axis=-1)
    return out_x, yc @ w_out


def conformer_conv(h, w_pw1, w_dw, b_dw, ln_g, ln_b, w_pw2):
    a = h @ w_pw1
    a1, a2 = jnp.split(a, 2, axis=-1)
    g = a1 * jax.nn.sigmoid(a2)
    half = CONV_WIDTH // 2
    y = lax.conv_general_dilated(g, w_dw[:, None, :], window_strides=(1,), padding=[(half, half)],
                                 dimension_numbers=('NWC', 'WIO', 'NWC'),
                                 feature_group_count=D_MODEL) + b_dw
    yf = y.astype(jnp.float32)
    mu = jnp.mean(yf, axis=-1, keepdims=True)
    var = jnp.mean(jnp.square(yf - mu), axis=-1, keepdims=True)
    yf = (yf - mu) * lax.rsqrt(var + NORM_EPS) * ln_g.astype(jnp.float32) + ln_b.astype(jnp.float32)
    y = (yf * jax.nn.sigmoid(yf)).astype(h.dtype)
    return y @ w_pw2


def sq_relu_mlp(h, w1, w2):
    return jnp.square(jax.nn.relu(h @ w1)) @ w2


def setup_inputs(seed: int = 0) -> dict:
    key = jax.random.key(seed)
    ks = jax.random.split(key, 24)
    f32 = jnp.float32
    D = D_MODEL

    def nrm(k, shape, s):
        return jax.random.normal(k, shape, f32) * s

    return {
        'x': nrm(ks[0], (BATCH, SEQ, D), 1.0),
        'c': nrm(ks[1], (BATCH, D), 1.0),
        'ctx': nrm(ks[2], (BATCH, CTX_LEN, D), 1.0),
        'c_ctx': nrm(ks[3], (D,), 1.0),
        'w_mod': nrm(ks[4], (DEPTH, D, 6 * D), 0.5 * D ** -0.5),
        'b_mod': nrm(ks[5], (DEPTH, 6 * D), 0.02),
        'norm1_g': 1.0 + nrm(ks[6], (DEPTH, D), 0.02),
        'norm2_g': 1.0 + nrm(ks[7], (DEPTH, D), 0.02),
        'mix_w_in': nrm(ks[8], (N_EVEN, D, IN_WIDTH), D ** -0.5),
        'pool_w': nrm(ks[9], (N_EVEN, N_POOL_GROUPS, POOL_GROUP, POOL_GROUP), POOL_GROUP ** -0.5),
        'pool_scale': 1.0 + nrm(ks[10], (N_EVEN, POOL_WIDTH), 0.02),
        'attn_sink': nrm(ks[11], (N_EVEN, N_Q_HEADS), 0.5),
        'mix_w_out': nrm(ks[12], (N_EVEN, POOL_WIDTH + Q_WIDTH, D), (POOL_WIDTH + Q_WIDTH) ** -0.5),
        'conv_w_pw1': nrm(ks[13], (N_ODD, D, 2 * D), D ** -0.5),
        'conv_w_dw': nrm(ks[14], (N_ODD, CONV_WIDTH, D), CONV_WIDTH ** -0.5),
        'conv_b_dw': nrm(ks[15], (N_ODD, D), 0.02),
        'conv_ln_g': 1.0 + nrm(ks[16], (N_ODD, D), 0.02),
        'conv_ln_b': nrm(ks[17], (N_ODD, D), 0.02),
        'conv_w_pw2': nrm(ks[18], (N_ODD, D, D), D ** -0.5),
        'mlp_w1': nrm(ks[19], (DEPTH, D, MLP_HIDDEN), D ** -0.5),
        'mlp_w2': nrm(ks[20], (DEPTH, MLP_HIDDEN, D), MLP_HIDDEN ** -0.5),
        'final_g': 1.0 + nrm(ks[21], (D,), 0.02),
    }


def reference(x, c, ctx, c_ctx, w_mod, b_mod, norm1_g, norm2_g, mix_w_in, pool_w, pool_scale,
              attn_sink, mix_w_out, conv_w_pw1, conv_w_dw, conv_b_dw, conv_ln_g, conv_ln_b,
              conv_w_pw2, mlp_w1, mlp_w2, final_g):
    S = x.shape[1]
    ang_r, ang_c = rope_angles(S)
    silu_c = jax.nn.silu(c)
    silu_cc = jax.nn.silu(c_ctx)
    last_reader = ((DEPTH - 1) // 2) * 2
    xc = ctx
    for l in range(DEPTH):
        mod = silu_c @ w_mod[l] + b_mod[l]
        sh1, sc1, g1, sh2, sc2, g2 = [m[:, None, :] for m in jnp.split(mod, 6, axis=-1)]
        need_ctx = l <= last_reader
        upd_ctx = l < last_reader
        if need_ctx:
            sh1c, sc1c, g1c, sh2c, sc2c, g2c = jnp.split(silu_cc @ w_mod[l] + b_mod[l], 6, axis=-1)
        hx = modulate(rms_norm(x, norm1_g[l]), sh1, sc1)
        if l % 2 == 0:
            i = l // 2
            hc = modulate(rms_norm(xc, norm1_g[l]), sh1c, sc1c)
            out_x, out_c = even_mixer(hx, hc, mix_w_in[i], pool_w[i], pool_scale[i], attn_sink[i],
                                      mix_w_out[i], ang_r, ang_c, upd_ctx)
        else:
            i = l // 2
            conv_args = (conv_w_pw1[i], conv_w_dw[i], conv_b_dw[i], conv_ln_g[i], conv_ln_b[i], conv_w_pw2[i])
            out_x = conformer_conv(hx, *conv_args)
            if upd_ctx:
                hc = modulate(rms_norm(xc, norm1_g[l]), sh1c, sc1c)
                out_c = conformer_conv(hc, *conv_args)
        x = x + g1 * out_x
        x = x + g2 * sq_relu_mlp(modulate(rms_norm(x, norm2_g[l]), sh2, sc2), mlp_w1[l], mlp_w2[l])
        if upd_ctx:
            xc = xc + g1c * out_c
            xc = xc + g2c * sq_relu_mlp(modulate(rms_norm(xc, norm2_g[l]), sh2c, sc2c), mlp_w1[l], mlp_w2[l])
    return rms_norm(x, final_g)
```

```cpp
#ifndef P_MOD
#define P_MOD 1
#endif
#ifndef P_TR
#define P_TR 1
#endif
#ifndef P_FOLD
#define P_FOLD 1
#endif
#ifndef P_SHW
#define P_SHW 1
#endif
#ifndef P_FIN
#define P_FIN 1
#endif
#ifndef P_L0N
#define P_L0N 1
#endif
#include <hip/hip_runtime.h>
#include <hip/hip_cooperative_groups.h>
#include <cstdio>
#include <cstdint>
namespace cg = cooperative_groups;
namespace pg8 {
#define PG8_LAS __attribute__((address_space(3)))
typedef unsigned short bf16_t;
typedef short bf16x8 __attribute__((ext_vector_type(8)));
typedef float f32x4 __attribute__((ext_vector_type(4)));
typedef unsigned u32x4 __attribute__((ext_vector_type(4)));
constexpr int BM = 256, BK = 64, HALF = 128, HTB = HALF * BK * 2  , STAGE_BYTES = 8 * HTB, NXCD = 8, WGM = 8;

__host__ __device__ __forceinline__ int lds_byte(int r, int c) { const int st = (r >> 4) * 2 + (c >> 5), rr = r & 15, cc = c & 31, ob = rr * 64 + cc * 2; return st * 1024 + (ob ^ (((ob >> 9) & 1) << 5)); }
__host__ __device__ __forceinline__ void stage_rc(int b, int& R, int& C) { const int st = b / 1024, sb = b % 1024, swz = sb ^ (((sb >> 9) & 1) << 5); R = (st >> 1) * 16 + swz / 64; C = (st & 1) * 32 + (swz % 64) / 2; }
__host__ __device__ __forceinline__ int perm32(int rho) { const int n = rho >> 4, i = rho & 15; return 8 * (i >> 2) + 4 * n + (i & 3); }

struct Unit { int pm, pn, kb, nt; };
struct Gemm { const bf16_t* A; const bf16_t* Bt; int M, N, K; };

struct StaticOrder {
    int nM, nN, nwg, G, c, ntf;
    __host__ __device__ void init(int M, int N, int G_, int c_, int K_) { nM = M / BM; nN = N / BM; nwg = nM * nN; G = G_; c = c_; ntf = K_ / BK; }
    __host__ __device__ bool next(int i, Unit& u) const {
        const long L = (long)i * G + c; if (L >= nwg) return false;
        int wgid = (int)L; { const int q = nwg / NXCD, r = nwg % NXCD, xcd = wgid % NXCD, off = wgid / NXCD; wgid = (xcd < r ? xcd * (q + 1) : r * (q + 1) + (xcd - r) * q) + off; }
        const int nig = WGM * nN, gid = wgid / nig, fm = gid * WGM, gsz = (nM - fm) < WGM ? (nM - fm) : WGM;
        u.pm = fm + ((wgid % nig) % gsz); u.pn = (wgid % nig) / gsz; u.kb = 0; u.nt = ntf; return true;
    }
    __device__ __forceinline__ void a_ready(const Unit&) const {}
    __device__ __forceinline__ void done(const Unit&) const {}
};

__device__ __forceinline__ unsigned cvt_pk_bf16(float lo, float hi) { unsigned r; asm volatile("v_cvt_pk_bf16_f32 %0, %1, %2" : "=v"(r) : "v"(lo), "v"(hi)); return r; }

struct RowScale {
    const float* RSS;
    const float* shw;
    __device__ __forceinline__ void load(const Unit& u, int wr, int wc, int fr, int fq, float (&rs)[2][4], f32x4 (&b)[2][2]) const {
        const int j = u.pm < 64 ? (u.pm >> 3) : 8, row0 = u.pm * BM + wr * 64 + fr;
#pragma unroll
        for (int ai = 0; ai < 2; ++ai)
#pragma unroll
            for (int m = 0; m < 4; ++m) { const f32x4 t = *(const f32x4*)(RSS + (size_t)(row0 + ai * HALF + m * 16) * 16 + 4 * fq);
                float sm = (t[0] + t[1]) + (t[2] + t[3]); sm += __shfl_xor(sm, 16); sm += __shfl_xor(sm, 32);
                rs[ai][m] = 1.f / sqrtf(sm * (1.f / 1024.f) + 1e-6f); }
        const float* bp = shw + j * 4096 + u.pn * BM + wc * 32 + 8 * fq;
#pragma unroll
        for (int bj = 0; bj < 2; ++bj)
#pragma unroll
            for (int n = 0; n < 2; ++n) b[bj][n] = *(const f32x4*)(bp + bj * HALF + 4 * n);
    }
};
struct EpiPX {
    static constexpr bool PERM = true, AFTER_DRAIN = false;
    bf16_t* O; const float* tab; float qscale; RowScale R;
    __device__ __forceinline__ void operator()(const f32x4 (&acc)[2][2][4][2], const Unit& u, int wr, int wc, int fr, int fq) const {
        const int row0 = u.pm * BM + wr * 64 + fr, col0 = u.pn * BM + wc * 32 + 8 * fq;
        const bool xrows = u.pm < 64, isq = (u.pn == 2 || u.pn == 3);
        const float sc = isq ? qscale : 1.f, sg = (fq & 2) ? 1.f : -1.f;
        float rs[2][4]; f32x4 bb[2][2]; R.load(u, wr, wc, fr, fq, rs, bb);
#pragma unroll
        for (int bj = 0; bj < 2; ++bj) {
            const bool rope = xrows && (isq || (u.pn == 4 && bj == 0));
#pragma unroll
            for (int ai = 0; ai < 2; ++ai)
#pragma unroll
                for (int m = 0; m < 4; ++m) {
                    const int row = row0 + ai * HALF + m * 16;
                    f32x4 v0 = acc[ai][bj][m][0] * rs[ai][m] + bb[bj][0], v1 = acc[ai][bj][m][1] * rs[ai][m] + bb[bj][1];
                    if (rope) {
                        const int s = row & 2047, pos = (wc & 1) ? (s & 63) : (s >> 6);
                        const float* tp = tab + pos * 16 + 8 * (fq & 1);
                        const f32x4 c0 = *(const f32x4*)tp, c1 = *(const f32x4*)(tp + 4), s0 = *(const f32x4*)(tp + 1024), s1 = *(const f32x4*)(tp + 1028);
                        f32x4 p0, p1;
#pragma unroll
                        for (int e = 0; e < 4; ++e) { p0[e] = __shfl_xor(v0[e], 32); p1[e] = __shfl_xor(v1[e], 32); }
                        v0 = v0 * c0 + (p0 * s0) * sg; v1 = v1 * c1 + (p1 * s1) * sg;
                    }
                    v0 = v0 * sc; v1 = v1 * sc;
                    u32x4 w; w.x = cvt_pk_bf16(v0[0], v0[1]); w.y = cvt_pk_bf16(v0[2], v0[3]); w.z = cvt_pk_bf16(v1[0], v1[1]); w.w = cvt_pk_bf16(v1[2], v1[3]);
                    *(u32x4*)(O + (size_t)row * 1280 + col0 + bj * HALF) = w;
                }
        }
    }
};
template <bool NEXT> struct EpiRes {
    static constexpr bool PERM = true, AFTER_DRAIN = false;
    float* X; const float* modl; int goff, ntfull; float* part;
    const float* gn; const float* scn; bf16_t* H; float* RSS;
    const float* Xin;
    __device__ __forceinline__ void operator()(const f32x4 (&acc)[2][2][4][2], const Unit& u, int wr, int wc, int fr, int fq) const {
        const int j = u.pm < 64 ? (u.pm >> 3) : 8;
        const int row0 = u.pm * BM + wr * 64 + fr, col0 = u.pn * BM + wc * 32 + 8 * fq;
        const float* gp = modl + j * 6144 + goff + col0;
        f32x4 gv[2][2];
#pragma unroll
        for (int bj = 0; bj < 2; ++bj)
#pragma unroll
            for (int n = 0; n < 2; ++n) gv[bj][n] = *(const f32x4*)(gp + bj * HALF + n * 4);
        if (u.nt == ntfull) {
        f32x4 mv[2][2];
        if (NEXT) {
#pragma unroll
            for (int bj = 0; bj < 2; ++bj)
#pragma unroll
                for (int n = 0; n < 2; ++n) mv[bj][n] = *(const f32x4*)(gn + col0 + bj * HALF + n * 4) * (*(const f32x4*)(scn + j * 6144 + col0 + bj * HALF + n * 4) + 1.f);
        }
#pragma unroll
        for (int ai = 0; ai < 2; ++ai)
#pragma unroll
            for (int m = 0; m < 4; ++m) { const size_t ro = (size_t)(row0 + ai * HALF + m * 16); float* rowp = X + ro * 1024 + col0; const float* rin = Xin + ro * 1024 + col0; float ss = 0.f;
#pragma unroll
                for (int bj = 0; bj < 2; ++bj) { f32x4 xn[2];
#pragma unroll
                    for (int n = 0; n < 2; ++n) { xn[n] = *(const f32x4*)(rin + bj * HALF + n * 4) + gv[bj][n] * acc[ai][bj][m][n]; *(f32x4*)(rowp + bj * HALF + n * 4) = xn[n]; }
                    if (NEXT) { ss += ((xn[0][0] * xn[0][0] + xn[0][1] * xn[0][1]) + (xn[0][2] * xn[0][2] + xn[0][3] * xn[0][3])) + ((xn[1][0] * xn[1][0] + xn[1][1] * xn[1][1]) + (xn[1][2] * xn[1][2] + xn[1][3] * xn[1][3]));
                        const f32x4 h0 = xn[0] * mv[bj][0], h1 = xn[1] * mv[bj][1];
                        u32x4 w; w.x = cvt_pk_bf16(h0[0], h0[1]); w.y = cvt_pk_bf16(h0[2], h0[3]); w.z = cvt_pk_bf16(h1[0], h1[1]); w.w = cvt_pk_bf16(h1[2], h1[3]);
                        *(u32x4*)(H + ro * 1024 + col0 + bj * HALF) = w; } }
                if (NEXT) { ss += __shfl_xor(ss, 16); ss += __shfl_xor(ss, 32); if (fq == 0) RSS[ro * 16 + u.pn * 4 + wc] = ss; } }
        } else {
        const int ks = u.kb / (u.nt * 128);
        bf16_t* pb = (bf16_t*)part;
#pragma unroll
        for (int ai = 0; ai < 2; ++ai)
#pragma unroll
            for (int m = 0; m < 4; ++m) { bf16_t* rowp = pb + ((size_t)ks * 2048 + (size_t)(row0 - 16384 + ai * HALF + m * 16)) * 1024 + col0;
#pragma unroll
                for (int bj = 0; bj < 2; ++bj) { const f32x4 p0 = gv[bj][0] * acc[ai][bj][m][0], p1 = gv[bj][1] * acc[ai][bj][m][1];
                    u32x4 w; w.x = cvt_pk_bf16(p0[0], p0[1]); w.y = cvt_pk_bf16(p0[2], p0[3]); w.z = cvt_pk_bf16(p1[0], p1[1]); w.w = cvt_pk_bf16(p1[2], p1[3]);
                    *(u32x4*)(rowp + bj * HALF) = w; } }
        }
    }
};
struct EpiSq {
    static constexpr bool PERM = true, AFTER_DRAIN = false;
    bf16_t* O; RowScale R;
    __device__ __forceinline__ void operator()(const f32x4 (&acc)[2][2][4][2], const Unit& u, int wr, int wc, int fr, int fq) const {
        const int row0 = u.pm * BM + wr * 64 + fr, col0 = u.pn * BM + wc * 32 + 8 * fq;
        float rs[2][4]; f32x4 bb[2][2]; R.load(u, wr, wc, fr, fq, rs, bb);
#pragma unroll
        for (int ai = 0; ai < 2; ++ai)
#pragma unroll
            for (int m = 0; m < 4; ++m) { bf16_t* rowp = O + (size_t)(row0 + ai * HALF + m * 16) * 4096 + col0;
#pragma unroll
                for (int bj = 0; bj < 2; ++bj) { f32x4 v0 = acc[ai][bj][m][0] * rs[ai][m] + bb[bj][0], v1 = acc[ai][bj][m][1] * rs[ai][m] + bb[bj][1];
#pragma unroll
                    for (int e = 0; e < 4; ++e) { const float a = fmaxf(v0[e], 0.f), b = fmaxf(v1[e], 0.f); v0[e] = a * a; v1[e] = b * b; }
                    u32x4 w; w.x = cvt_pk_bf16(v0[0], v0[1]); w.y = cvt_pk_bf16(v0[2], v0[3]); w.z = cvt_pk_bf16(v1[0], v1[1]); w.w = cvt_pk_bf16(v1[2], v1[3]);
                    *(u32x4*)(rowp + bj * HALF) = w; } }
    }
};
struct EpiGLU {
    static constexpr bool PERM = true, AFTER_DRAIN = false;
    bf16_t* O; RowScale R;
    __device__ __forceinline__ void operator()(const f32x4 (&acc)[2][2][4][2], const Unit& u, int wr, int wc, int fr, int fq) const {
        const int row0 = u.pm * BM + wr * 64 + fr, col0 = u.pn * HALF + wc * 32 + 8 * fq;
        float rs[2][4]; f32x4 bb[2][2]; R.load(u, wr, wc, fr, fq, rs, bb);
#pragma unroll
        for (int ai = 0; ai < 2; ++ai)
#pragma unroll
            for (int m = 0; m < 4; ++m) {
                f32x4 v[2];
#pragma unroll
                for (int n = 0; n < 2; ++n)
#pragma unroll
                    for (int e = 0; e < 4; ++e) { const float a1 = acc[ai][0][m][n][e] * rs[ai][m] + bb[0][n][e], a2 = acc[ai][1][m][n][e] * rs[ai][m] + bb[1][n][e]; v[n][e] = a1 * __builtin_amdgcn_rcpf(1.f + __expf(-a2)); }
                u32x4 w; w.x = cvt_pk_bf16(v[0][0], v[0][1]); w.y = cvt_pk_bf16(v[0][2], v[0][3]); w.z = cvt_pk_bf16(v[1][0], v[1][1]); w.w = cvt_pk_bf16(v[1][2], v[1][3]);
                *(u32x4*)(O + (size_t)(row0 + ai * HALF + m * 16) * 1024 + col0) = w;
            }
    }
};
template <class Epi, class Sched, bool ALIGN_EPI = false, bool SP2 = false>
__device__ __forceinline__ void gemm_phase(PG8_LAS unsigned char* lds, const Gemm g, const Sched& S, const Epi& E) {
    const int tid = threadIdx.x, wid = __builtin_amdgcn_readfirstlane(tid >> 6), lane = tid & 63, wr = wid >> 2, wc = wid & 3, fr = lane & 15, fq = lane >> 4;
    const int K = g.K;
    unsigned voffA[2], voffB[2];
#pragma unroll
    for (int i = 0; i < 2; ++i) { int R, C; stage_rc(tid * 16 + i * 8192, R, C); const int Rb = Epi::PERM ? ((R & ~31) + perm32(R & 31)) : R;
        voffA[i] = (unsigned)(R * K + C) * 2u; voffB[i] = (unsigned)(Rb * K + C) * 2u; }
    const size_t kstep = (size_t)(BK * 2);
    const size_t hstep = (size_t)HALF * K * 2;
    const size_t tstep = 2 * hstep;
    const unsigned ldsw = (unsigned)wid * 1024u;
    const int aoff = lds_byte(wr * 64 + fr, fq * 8), boff = lds_byte(wc * 32 + fr, fq * 8);
#define PG8_SA(b, h) (((b) * 2 + (h)) * HTB)
#define PG8_SB(b, h) ((4 + (b) * 2 + (h)) * HTB)
#define PG8_STAGE(bufoff, gbase, voff) do { _Pragma("unroll") for (int _i = 0; _i < 2; ++_i) \
        __builtin_amdgcn_global_load_lds((const unsigned*)((const char*)(gbase) + (voff)[_i]), (PG8_LAS unsigned*)(lds + (bufoff) + ldsw + _i * 8192), 16, 0, 0); } while (0)
#define PG8_LDA(dst, b, h) do { _Pragma("unroll") for (int m = 0; m < 4; ++m) _Pragma("unroll") for (int k = 0; k < 2; ++k) dst[m][k] = *(const PG8_LAS bf16x8*)(lds + PG8_SA(b, h) + aoff + m * 2048 + k * 1024); } while (0)
#define PG8_LDB(dst, b, h) do { _Pragma("unroll") for (int n = 0; n < 2; ++n) _Pragma("unroll") for (int k = 0; k < 2; ++k) dst[n][k] = *(const PG8_LAS bf16x8*)(lds + PG8_SB(b, h) + boff + n * 2048 + k * 1024); } while (0)
#define PG8_MMA(ai, bj, At, Bt) do { __builtin_amdgcn_s_setprio(1); _Pragma("unroll") for (int m = 0; m < 4; ++m) _Pragma("unroll") for (int n = 0; n < 2; ++n) _Pragma("unroll") for (int k = 0; k < 2; ++k) \
        acc[ai][bj][m][n] = __builtin_amdgcn_mfma_f32_16x16x32_bf16(Bt[n][k], At[m][k], acc[ai][bj][m][n], 0, 0, 0); __builtin_amdgcn_s_setprio(0); } while (0)
#define PG8_WAIT_V(n) asm volatile("s_waitcnt vmcnt(" #n ")" ::: "memory")
#define PG8_WAIT_L(n) asm volatile("s_waitcnt lgkmcnt(" #n ")" ::: "memory")
#define PG8_BAR __builtin_amdgcn_s_barrier()
#define PG8_SCHED __builtin_amdgcn_sched_barrier(0)
    Unit cur, nxt; int ui = 0;
    if (!S.next(0, cur)) return;
    f32x4 acc[2][2][4][2];
#pragma unroll
    for (int a = 0; a < 2; ++a)
#pragma unroll
        for (int b = 0; b < 2; ++b)
#pragma unroll
            for (int m = 0; m < 4; ++m)
#pragma unroll
                for (int n = 0; n < 2; ++n) acc[a][b][m][n] = (f32x4){0.f, 0.f, 0.f, 0.f};
    bf16x8 At[4][2], B0[2][2], B1[2][2];
    const char* cA = (const char*)g.A + (size_t)cur.pm * tstep + cur.kb; const char* cB = (const char*)g.Bt + (size_t)cur.pn * tstep + cur.kb;
    S.a_ready(cur);
    if constexpr (SP2) {
        PG8_STAGE(PG8_SB(0, 0), cB, voffB); PG8_STAGE(PG8_SB(0, 1), cB + hstep, voffB); PG8_STAGE(PG8_SA(0, 0), cA, voffA); PG8_STAGE(PG8_SA(0, 1), cA + hstep, voffA);
        if (wr == 1) PG8_BAR;
        PG8_WAIT_V(2); PG8_BAR;
        PG8_STAGE(PG8_SB(1, 0), cB + kstep, voffB); PG8_STAGE(PG8_SA(1, 0), cA + kstep, voffA); PG8_STAGE(PG8_SB(1, 1), cB + hstep + kstep, voffB);
        PG8_WAIT_V(6); PG8_BAR;
    } else {
        PG8_STAGE(PG8_SB(0, 0), cB, voffB); PG8_STAGE(PG8_SA(0, 0), cA, voffA); PG8_STAGE(PG8_SB(0, 1), cB + hstep, voffB); PG8_STAGE(PG8_SA(0, 1), cA + hstep, voffA);
        if (wr == 1) PG8_BAR;
        PG8_WAIT_V(4); PG8_BAR;
        PG8_STAGE(PG8_SB(1, 0), cB + kstep, voffB); PG8_STAGE(PG8_SA(1, 0), cA + kstep, voffA); PG8_STAGE(PG8_SB(1, 1), cB + hstep + kstep, voffB);
        PG8_WAIT_V(6); PG8_BAR;
    }
    for (;;) {
        const bool has_next = S.next(ui + 1, nxt);
        const char* nA = has_next ? (const char*)g.A + (size_t)nxt.pm * tstep + nxt.kb : cA; const char* nB = has_next ? (const char*)g.Bt + (size_t)nxt.pn * tstep + nxt.kb : cB;
        const int nt = cur.nt;
        for (int t = 0; t < nt; t += 2) {
            const bool last = (t == nt - 2);
            const char* a1 = cA + (size_t)(t + 1) * kstep;
            const char* a2 = last ? nA : cA + (size_t)(t + 2) * kstep; const char* b2 = last ? nB : cB + (size_t)(t + 2) * kstep;
            const char* a3 = a2 + kstep; const char* b3 = b2 + kstep;
            if (last && has_next) S.a_ready(nxt);
            if constexpr (SP2) {
            PG8_LDB(B0, 0, 0); PG8_LDB(B1, 0, 1); PG8_SCHED; PG8_LDA(At, 0, 0); PG8_STAGE(PG8_SA(1, 1), a1 + hstep, voffA);
            PG8_WAIT_V(8); PG8_WAIT_L(0); PG8_BAR; PG8_MMA(0, 0, At, B0); PG8_MMA(0, 1, At, B1); PG8_BAR; PG8_SCHED;
            PG8_LDA(At, 0, 1); PG8_STAGE(PG8_SB(0, 0), b2, voffB); PG8_STAGE(PG8_SB(0, 1), b2 + hstep, voffB); PG8_STAGE(PG8_SA(0, 0), a2, voffA);
            PG8_WAIT_V(8); PG8_WAIT_L(0); PG8_BAR; PG8_MMA(1, 0, At, B0); PG8_MMA(1, 1, At, B1); PG8_BAR; PG8_SCHED;
            PG8_LDB(B0, 1, 0); PG8_LDB(B1, 1, 1); PG8_SCHED; PG8_LDA(At, 1, 0); PG8_STAGE(PG8_SA(0, 1), a2 + hstep, voffA);
            PG8_WAIT_V(8); PG8_WAIT_L(0); PG8_BAR; PG8_MMA(0, 0, At, B0); PG8_MMA(0, 1, At, B1); PG8_BAR; PG8_SCHED;
            PG8_LDA(At, 1, 1); PG8_STAGE(PG8_SB(1, 0), b3, voffB); PG8_STAGE(PG8_SB(1, 1), b3 + hstep, voffB); PG8_STAGE(PG8_SA(1, 0), a3, voffA);
            PG8_WAIT_V(8); PG8_WAIT_L(0); PG8_BAR; PG8_MMA(1, 0, At, B0); PG8_MMA(1, 1, At, B1); PG8_BAR; PG8_SCHED;
            } else {
            PG8_LDB(B0, 0, 0); PG8_SCHED; PG8_LDA(At, 0, 0); PG8_STAGE(PG8_SA(1, 1), a1 + hstep, voffA);
            PG8_WAIT_L(8); PG8_BAR; PG8_WAIT_L(0); PG8_MMA(0, 0, At, B0); PG8_BAR; PG8_SCHED;
            PG8_LDB(B1, 0, 1); PG8_STAGE(PG8_SB(0, 0), b2, voffB);
            PG8_BAR; PG8_WAIT_L(0); PG8_MMA(0, 1, At, B1); PG8_BAR;
            PG8_LDA(At, 0, 1); PG8_STAGE(PG8_SA(0, 0), a2, voffA);
            PG8_BAR; PG8_WAIT_L(0); PG8_MMA(1, 0, At, B0); PG8_BAR; PG8_SCHED;
            PG8_STAGE(PG8_SB(0, 1), b2 + hstep, voffB);
            PG8_WAIT_V(6); PG8_BAR; PG8_MMA(1, 1, At, B1); PG8_BAR;
            PG8_LDB(B0, 1, 0); PG8_SCHED; PG8_LDA(At, 1, 0); PG8_STAGE(PG8_SA(0, 1), a2 + hstep, voffA);
            PG8_WAIT_L(8); PG8_BAR; PG8_WAIT_L(0); PG8_MMA(0, 0, At, B0); PG8_BAR; PG8_SCHED;
            PG8_LDB(B1, 1, 1); PG8_STAGE(PG8_SB(1, 0), b3, voffB);
            PG8_BAR; PG8_WAIT_L(0); PG8_MMA(0, 1, At, B1); PG8_BAR;
            PG8_LDA(At, 1, 1); PG8_STAGE(PG8_SA(1, 0), a3, voffA);
            PG8_BAR; PG8_WAIT_L(0); PG8_MMA(1, 0, At, B0); PG8_BAR; PG8_SCHED;
            PG8_STAGE(PG8_SB(1, 1), b3 + hstep, voffB);
            PG8_WAIT_V(6); PG8_BAR; PG8_MMA(1, 1, At, B1); PG8_BAR;
            }
        }
        if constexpr (ALIGN_EPI) { if (wr == 0) PG8_BAR; }
        if constexpr (!Epi::AFTER_DRAIN) { E(acc, cur, wr, wc, fr, fq); S.done(cur); }
        if (!has_next) break;
#pragma unroll
        for (int a = 0; a < 2; ++a)
#pragma unroll
            for (int b = 0; b < 2; ++b)
#pragma unroll
                for (int m = 0; m < 4; ++m)
#pragma unroll
                    for (int n = 0; n < 2; ++n) acc[a][b][m][n] = (f32x4){0.f, 0.f, 0.f, 0.f};
        cur = nxt; cA = nA; cB = nB; ++ui;
        if constexpr (ALIGN_EPI) { if (wr == 1) PG8_BAR; }
    }
    PG8_WAIT_V(0);
    if constexpr (!ALIGN_EPI) { if (wr == 0) PG8_BAR; }
    PG8_BAR;
    if constexpr (Epi::AFTER_DRAIN) { E.fused(acc, cur, wr, wc, fr, fq, lds, wid, lane); S.done(cur); }
#undef PG8_SA
#undef PG8_SB
#undef PG8_STAGE
#undef PG8_LDA
#undef PG8_LDB
#undef PG8_MMA
#undef PG8_WAIT_V
#undef PG8_WAIT_L
#undef PG8_BAR
#undef PG8_SCHED
}
}

#ifndef MK_COOP
#define MK_COOP 1
#endif
#define DI __device__ __forceinline__
#define LAS __attribute__((address_space(3)))
typedef unsigned short bf16;
typedef unsigned v4u __attribute__((ext_vector_type(4)));
typedef unsigned v2u __attribute__((ext_vector_type(2)));
typedef float f32x4 __attribute__((ext_vector_type(4)));
typedef float f32x2 __attribute__((ext_vector_type(2)));
typedef float f32x16 __attribute__((ext_vector_type(16)));
typedef short bf16x8 __attribute__((ext_vector_type(8)));
typedef short s16x4 __attribute__((ext_vector_type(4)));
typedef __bf16 bf16v2 __attribute__((ext_vector_type(2)));

constexpr int D = 1024, NB = 8, SEQ = 2048, CTXL = 256, TX = NB * SEQ, TC = NB * CTXL, TT = TX + TC;
constexpr int INW = 1280, HIDN = 4096, NPHASE = 30;
constexpr float NORM_EPS = 1e-6f, LOG2E = 1.4426950408889634f;

constexpr size_t MiB = 1u << 20;
constexpr size_t WS_MOD = 0, WS_TAB = 1 * MiB, WS_BAR = 1 * MiB + 65536, BAR_BYTES = 16384, WS_ZERO = WS_BAR + BAR_BYTES;
constexpr size_t WS_WIN = 2 * MiB, WS_WOUT = 7 * MiB, WS_PW1 = 11 * MiB, WS_PW2 = 19 * MiB, WS_W1 = 23 * MiB, WS_W2 = 55 * MiB;
constexpr size_t WS_X = 88 * MiB, WS_H = 160 * MiB, WS_HID = 196 * MiB, WS_PX = 196 * MiB, WS_A2 = 244 * MiB, WS_PART = 340 * MiB, WS_RSS = 372 * MiB, WS_SHW = 374 * MiB, WS_END = 376 * MiB;
constexpr int LDS_BYTES = 147456;

#define LDS_WAIT() asm volatile("s_waitcnt lgkmcnt(0)" ::: "memory")
DI unsigned f2bf(float f) { unsigned u = __builtin_bit_cast(unsigned, f); return (u + 0x7fffu + ((u >> 16) & 1u)) >> 16; }
DI unsigned pk2(float lo, float hi) { return __builtin_bit_cast(unsigned, __builtin_convertvector((f32x2){lo, hi}, bf16v2)); }
DI float bflo(unsigned u) { return __builtin_bit_cast(float, u << 16); }
DI float bfhi(unsigned u) { return __builtin_bit_cast(float, u & 0xffff0000u); }
DI float wave_sum(float v) {
#pragma unroll
    for (int o = 1; o < 64; o <<= 1) v += __shfl_xor(v, o);
    return v;
}

struct Args { const float* in[22]; float* out; unsigned char* ws; int ph_lo, ph_hi; };

DI int glurow(int n) { return n < 1024 ? 256 * (n >> 7) + (n & 127) : 256 * ((n - 1024) >> 7) + 128 + (n & 127); }
DI void transpose_item(const float* W, int N, int ksrc0, bf16* WT, int Kdst, int kdst0, int nblk, int item, bool glu, LAS float* scr, int lane) {
    const int kb = item / nblk, nb = item % nblk, k0 = 64 * kb, n0 = 32 * nb;
    float tv[32];
#pragma unroll
    for (int i = 0; i < 32; ++i) { const int kk = 2 * i + (lane >> 5); tv[i] = W[(size_t)(ksrc0 + k0 + kk) * N + n0 + (lane & 31)]; }
#pragma unroll
    for (int i = 0; i < 32; ++i) { const int kk = 2 * i + (lane >> 5); scr[kk * 33 + (lane & 31)] = tv[i]; }
    LDS_WAIT(); asm volatile("" ::: "memory");
    const int c = lane & 7;
#pragma unroll
    for (int j = 0; j < 4; ++j) { const int n = (lane >> 3) + 8 * j; const LAS float* s = scr + (8 * c) * 33 + n;
        v4u o; o.x = pk2(s[0 * 33], s[1 * 33]); o.y = pk2(s[2 * 33], s[3 * 33]); o.z = pk2(s[4 * 33], s[5 * 33]); o.w = pk2(s[6 * 33], s[7 * 33]);
        const int ncol = n0 + n, row = glu ? glurow(ncol) : ncol;
        *(v4u*)(WT + (size_t)row * Kdst + kdst0 + k0 + 8 * c) = o; }
    LDS_WAIT(); asm volatile("" ::: "memory");
}
DI void fold_item(const float* pool_w, const float* pool_scale, const float* w_out, bf16* WoutT, int item, int lane) {
    const int rb = item & 7, no = item >> 3, g = rb >> 1, r = 64 * rb + lane, c = r & 127, n0 = 8 * no;
    const float* pw = pool_w + ((size_t)g * 128 + c) * 128; const float* ps = pool_scale + 128 * g; const float* wo = w_out + (size_t)(128 * g) * 1024 + n0;
    f32x4 a0 = {0.f, 0.f, 0.f, 0.f}, a1 = {0.f, 0.f, 0.f, 0.f};
#pragma unroll 4
    for (int d4 = 0; d4 < 32; ++d4) { const f32x4 pv = *(const f32x4*)(pw + 4 * d4);
#pragma unroll
        for (int e = 0; e < 4; ++e) { const int d = 4 * d4 + e; const float p = pv[e] * ps[d]; const f32x4 w0 = *(const f32x4*)(wo + (size_t)d * 1024), w1 = *(const f32x4*)(wo + (size_t)d * 1024 + 4); a0 += w0 * p; a1 += w1 * p; } }
#pragma unroll
    for (int q = 0; q < 4; ++q) { WoutT[(size_t)(n0 + q) * 1024 + r] = (bf16)f2bf(a0[q]); WoutT[(size_t)(n0 + 4 + q) * 1024 + r] = (bf16)f2bf(a1[q]); }
}
DI void phase_prep(const Args& a, LAS unsigned char* lds, int G) {
    const int tid = threadIdx.x, lane = tid & 63, wave = __builtin_amdgcn_readfirstlane(tid >> 6);
    unsigned char* ws = a.ws;
    if (blockIdx.x == (unsigned)(G - 1) && tid < 16) {
        float* tab = (float*)(ws + WS_TAB);
        double theta = 1.0; for (int k = 0; k < tid; ++k) theta *= 0.5623413251903491;
        const double t2 = theta * theta; double c = 1.0, s = theta, tc = 1.0, ts = theta;
        for (int n = 1; n <= 12; ++n) { tc *= -t2 / (double)((2 * n - 1) * (2 * n)); c += tc; ts *= -t2 / (double)((2 * n) * (2 * n + 1)); s += ts; }
        double cc = 1.0, ss = 0.0;
        for (int p = 0; p < 64; ++p) { tab[p * 16 + tid] = (float)cc; tab[1024 + p * 16 + tid] = (float)ss; const double nc = cc * c - ss * s; ss = ss * c + cc * s; cc = nc; }
    }
    if ((int)blockIdx.x < 384) {
        LAS float* st = (LAS float*)lds;
        LAS float* red = (LAS float*)(lds + 36864);
        for (int idx = tid; idx < 9 * 1024; idx += 512) { const int j = idx >> 10, k = idx & 1023; const float v = j < 8 ? a.in[1][j * 1024 + k] : a.in[3][k]; st[idx] = v / (1.f + __expf(-v)); }
        __syncthreads();
        float* MOD = (float*)(ws + WS_MOD);
        for (int pr_ = 0; pr_ < P_MOD; ++pr_)
        for (int it = blockIdx.x; it < 384; it += G) {
            const int l = it / 96, n0 = (it % 96) * 64;
            const float* wp = a.in[4] + ((size_t)l * 1024 + wave * 128) * 6144 + n0 + lane;
            float acc[9];
#pragma unroll
            for (int j = 0; j < 9; ++j) acc[j] = 0.f;
#pragma unroll 8
            for (int k4 = 0; k4 < 32; ++k4) {
                float w[4];
#pragma unroll
                for (int e = 0; e < 4; ++e) w[e] = wp[(size_t)(4 * k4 + e) * 6144];
#pragma unroll
                for (int j = 0; j < 9; ++j) { const f32x4 sv = *(const LAS f32x4*)(st + j * 1024 + wave * 128 + 4 * k4); acc[j] += sv[0] * w[0] + sv[1] * w[1] + sv[2] * w[2] + sv[3] * w[3]; }
            }
#pragma unroll
            for (int j = 0; j < 9; ++j) red[(wave * 9 + j) * 64 + lane] = acc[j];
            __syncthreads();
            for (int idx = tid; idx < 576; idx += 512) { const int j = idx >> 6, ln = idx & 63; float s = a.in[5][l * 6144 + n0 + ln];
#pragma unroll
                for (int w8 = 0; w8 < 8; ++w8) s += red[(w8 * 9 + j) * 64 + ln];
                MOD[((size_t)l * 9 + j) * 6144 + n0 + ln] = s; }
            __syncthreads();
        }
    }
    LAS float* scr = (LAS float*)(lds + 57344 + wave * 8704);
    const int gw = blockIdx.x * 8 + wave, NGW = G * 8;
    bf16* WinT = (bf16*)(ws + WS_WIN); bf16* WoutT = (bf16*)(ws + WS_WOUT); bf16* Pw1T = (bf16*)(ws + WS_PW1); bf16* Pw2T = (bf16*)(ws + WS_PW2); bf16* W1T = (bf16*)(ws + WS_W1); bf16* W2T = (bf16*)(ws + WS_W2);
    constexpr int I_WIN = 16 * 40, I_WOA = 8 * 32, I_PW1 = 16 * 64, I_PW2 = 16 * 32, I_W1 = 16 * 128, I_W2 = 64 * 32;
    constexpr int NITEMS = 2 * I_WIN + 2 * I_WOA + 2 * I_PW1 + 2 * I_PW2 + 4 * I_W1 + 4 * I_W2;
    for (int pr_ = 0; pr_ < P_FOLD; ++pr_)
    for (int it = gw; it < 2048; it += NGW) { const int l = it >> 10; fold_item(a.in[9] + (size_t)l * 4 * 128 * 128, a.in[10] + l * 512, a.in[12] + (size_t)l * D * D, WoutT + (size_t)l * D * D, __builtin_amdgcn_readfirstlane(it & 1023), lane); }
    for (int pr_ = 0; pr_ < P_TR; ++pr_)
    for (int it = gw; it < NITEMS; it += NGW) {
        int r = it;
        if (r < 4 * I_W1) { const int l = r / I_W1; transpose_item(a.in[19] + (size_t)l * D * HIDN, HIDN, 0, W1T + (size_t)l * D * HIDN, D, 0, HIDN / 32, r % I_W1, false, scr, lane); continue; } r -= 4 * I_W1;
        if (r < 4 * I_W2) { const int l = r / I_W2; transpose_item(a.in[20] + (size_t)l * D * HIDN, D, 0, W2T + (size_t)l * D * HIDN, HIDN, 0, D / 32, r % I_W2, false, scr, lane); continue; } r -= 4 * I_W2;
        if (r < 2 * I_WIN) { const int l = r / I_WIN; transpose_item(a.in[8] + (size_t)l * D * INW, INW, 0, WinT + (size_t)l * D * INW, D, 0, INW / 32, r % I_WIN, false, scr, lane); continue; } r -= 2 * I_WIN;
        if (r < 2 * I_WOA) { const int l = r / I_WOA; transpose_item(a.in[12] + (size_t)l * D * D, D, 512, WoutT + (size_t)l * D * D, D, 512, D / 32, r % I_WOA, false, scr, lane); continue; } r -= 2 * I_WOA;
        if (r < 2 * I_PW1) { const int l = r / I_PW1; transpose_item(a.in[13] + (size_t)l * D * 2048, 2048, 0, Pw1T + (size_t)l * D * 2048, D, 0, 2048 / 32, r % I_PW1, true, scr, lane); continue; } r -= 2 * I_PW1;
        { const int l = r / I_PW2; transpose_item(a.in[18] + (size_t)l * D * D, D, 0, Pw2T + (size_t)l * D * D, D, 0, D / 32, r % I_PW2, false, scr, lane); }
    }
}

template <int MODE, int NSPLIT> DI void phase_norm(const Args& a, int G, int rbeg, int rend, const float* gvec, const float* modl, int sci) {
    const int tid = threadIdx.x, lane = tid & 63, wave = tid >> 6, gw = blockIdx.x * 8 + wave, NGW = G * 8;
    float* X = (float*)(a.ws + WS_X); bf16* H = (bf16*)(a.ws + WS_H); float* RSS = (float*)(a.ws + WS_RSS);
#define PN_SRC(r_) (MODE == 1 ? ((r_) < TX ? a.in[0] + (size_t)(r_) * D : a.in[2] + (size_t)((r_) - TX) * D) : (MODE == 2 ? a.in[2] + (size_t)((r_) - TX) * D : X + (size_t)(r_) * D))
    f32x4 vn[4];
    { const int r = rbeg + gw; if (r < rend) { const f32x4* s4 = (const f32x4*)PN_SRC(r) + lane;
#pragma unroll
        for (int q = 0; q < 4; ++q) vn[q] = s4[64 * q]; } }
#pragma unroll 1
    for (int r = rbeg + gw; r < rend; r += NGW) {
        const int j = r < TX ? (r >> 11) : 8;
        f32x4 v[4]; float ss = 0.f;
#pragma unroll
        for (int q = 0; q < 4; ++q) v[q] = vn[q];
        { const int rn = r + NGW; if (rn < rend) { const f32x4* s4 = (const f32x4*)PN_SRC(rn) + lane;
#pragma unroll
            for (int q = 0; q < 4; ++q) vn[q] = s4[64 * q]; } }
        if (MODE != 1) {
            const v2u* p2 = (const v2u*)(a.ws + WS_PART) + (size_t)(r - TX) * 256 + lane;
#pragma unroll
            for (int ks = 0; ks < NSPLIT; ++ks)
#pragma unroll
                for (int q = 0; q < 4; ++q) { const v2u u2 = p2[(size_t)ks * 2048 * 256 + 64 * q]; v[q] += (f32x4){bflo(u2.x), bfhi(u2.x), bflo(u2.y), bfhi(u2.y)}; }
        }
#pragma unroll
        for (int q = 0; q < 4; ++q) { if (MODE != 1) ((f32x4*)(X + (size_t)r * D))[lane + 64 * q] = v[q]; ss += (v[q][0] * v[q][0] + v[q][1] * v[q][1]) + (v[q][2] * v[q][2] + v[q][3] * v[q][3]); }
        ss = wave_sum(ss);
        if (lane < 16) RSS[(size_t)r * 16 + lane] = lane == 0 ? ss : 0.f;
        const f32x4* g4 = (const f32x4*)gvec + lane; const f32x4* sc4 = (const f32x4*)(modl + j * 6144 + sci * 1024) + lane;
#pragma unroll
        for (int q = 0; q < 4; ++q) {
            const f32x4 y = (v[q] * g4[64 * q]) * (sc4[64 * q] + 1.f);
            v2u o; o.x = pk2(y[0], y[1]); o.y = pk2(y[2], y[3]);
            *(v2u*)(H + (size_t)r * D + 4 * (lane + 64 * q)) = o;
        }
    }
#undef PN_SRC
}
DI void phase_shw(const Args& a, int G) {
    const int tid = threadIdx.x, lane = tid & 63, wave = tid >> 6, gw = blockIdx.x * 8 + wave, NGW = G * 8;
    const float* MOD = (const float*)(a.ws + WS_MOD); float* SHW = (float*)(a.ws + WS_SHW);
    constexpr int NGRP = (2 * 1280 + 2 * 2048 + 4 * 4096) / 32;
    const int r = lane & 31, h = lane >> 5, j = r;
#pragma unroll 1
    for (int grp = gw; grp < NGRP; grp += NGW) {
        const int it = grp * 32; int l, slot, n0; const bf16* bt;
        if (it < 4 * 4096) { l = it >> 12; slot = 1; n0 = it & 4095; bt = (const bf16*)(a.ws + WS_W1) + ((size_t)l * HIDN + n0) * D; }
        else if (it < 4 * 4096 + 2 * 1280) { const int q = it - 4 * 4096; l = 2 * (q / 1280); slot = 0; n0 = q % 1280; bt = (const bf16*)(a.ws + WS_WIN) + ((size_t)(l >> 1) * INW + n0) * D; }
        else { const int q = it - 4 * 4096 - 2 * 1280; l = 2 * (q >> 11) + 1; slot = 0; n0 = q & 2047; bt = (const bf16*)(a.ws + WS_PW1) + ((size_t)(l >> 1) * 2048 + n0) * D; }
        const bf16* ap = bt + (size_t)r * D + 8 * h;
        const float* sp = MOD + ((size_t)l * 9 + (j < 9 ? j : 0)) * 6144 + (slot ? 3 : 0) * 1024 + 8 * h;
        f32x16 acc;
#pragma unroll
        for (int i = 0; i < 16; ++i) acc[i] = 0.f;
#pragma unroll 8
        for (int s = 0; s < 64; ++s) {
            const bf16x8 av = *(const bf16x8*)(ap + 16 * s);
            v4u bw = {0u, 0u, 0u, 0u};
            if (j < 9) { const f32x4 s0 = *(const f32x4*)(sp + 16 * s), s1 = *(const f32x4*)(sp + 16 * s + 4); bw.x = pk2(s0[0], s0[1]); bw.y = pk2(s0[2], s0[3]); bw.z = pk2(s1[0], s1[1]); bw.w = pk2(s1[2], s1[3]); }
            acc = __builtin_amdgcn_mfma_f32_32x32x16_bf16(av, __builtin_bit_cast(bf16x8, bw), acc, 0, 0, 0);
        }
        if (j < 9) { float* op = SHW + (((size_t)l * 2 + slot) * 9 + j) * 4096 + n0 + 4 * h;
#pragma unroll
            for (int i = 0; i < 16; ++i) op[(i & 3) + 8 * (i >> 2)] = acc[i]; }
    }
}
DI void phase_final(const Args& a, int G) {
    const int tid = threadIdx.x, lane = tid & 63, wave = tid >> 6, gw = blockIdx.x * 8 + wave, NGW = G * 8;
    const float* X = (const float*)(a.ws + WS_X);
    const f32x4* g4 = (const f32x4*)a.in[21] + lane;
    const bool al = (G & 7) == 0;
    const int lw = ((int)blockIdx.x >> 3) * 8 + wave, nlw = (G >> 3) * 8;
    for (int it_ = 0; al ? (lw + it_ * nlw < SEQ) : (gw + it_ * NGW < TX); it_ += 2) {
        const int r = al ? ((int)blockIdx.x & 7) * SEQ + lw + it_ * nlw : gw + it_ * NGW;
        const int r1 = al ? r + nlw : r + NGW; const bool has1 = al ? (lw + (it_ + 1) * nlw < SEQ) : (r1 < TX);
        const f32x4* s0 = (const f32x4*)(X + (size_t)r * D) + lane; const f32x4* s1 = (const f32x4*)(X + (size_t)(has1 ? r1 : r) * D) + lane;
        f32x4 v0[4], v1[4]; float ss0 = 0.f, ss1 = 0.f;
#pragma unroll
        for (int q = 0; q < 4; ++q) { v0[q] = s0[64 * q]; v1[q] = s1[64 * q]; }
#pragma unroll
        for (int q = 0; q < 4; ++q) { ss0 += (v0[q][0] * v0[q][0] + v0[q][1] * v0[q][1]) + (v0[q][2] * v0[q][2] + v0[q][3] * v0[q][3]); ss1 += (v1[q][0] * v1[q][0] + v1[q][1] * v1[q][1]) + (v1[q][2] * v1[q][2] + v1[q][3] * v1[q][3]); }
#pragma unroll
        for (int o = 1; o < 64; o <<= 1) { ss0 += __shfl_xor(ss0, o); ss1 += __shfl_xor(ss1, o); }
        const float rs0 = 1.f / sqrtf(ss0 * (1.f / D) + NORM_EPS), rs1 = 1.f / sqrtf(ss1 * (1.f / D) + NORM_EPS);
#pragma unroll
        for (int q = 0; q < 4; ++q) { ((f32x4*)(a.out + (size_t)r * D))[lane + 64 * q] = v0[q] * rs0 * g4[64 * q]; if (has1) ((f32x4*)(a.out + (size_t)r1 * D))[lane + 64 * q] = v1[q] * rs1 * g4[64 * q]; }
    }
}

DI void phase_pool(const Args& a, int G, int nrows) {
    const int tid = threadIdx.x, lane = tid & 63, wave = tid >> 6, gw = blockIdx.x * 8 + wave, NGW = G * 8;
    const bf16* PX = (const bf16*)(a.ws + WS_PX); bf16* A2 = (bf16*)(a.ws + WS_A2);
    const int g = lane >> 4, half = 1 << g, ch = 8 * lane;
#pragma unroll 1
    for (int cs = gw; cs < nrows / 8; cs += NGW) {
        const int wgs = cs >> 3, ngr = nrows / 64, c = ((G & 7) == 0 && (ngr & 7) == 0) ? ((wgs & 7) * (ngr >> 3) + (wgs >> 3)) * 8 + (cs & 7) : cs;
        const int r0 = 8 * c; int seq_lo, Ls; if (r0 < TX) { seq_lo = r0 & ~(SEQ - 1); Ls = SEQ; } else { seq_lo = TX + ((r0 - TX) & ~(CTXL - 1)); Ls = CTXL; }
        const int seq_hi = seq_lo + Ls;
        v4u raw[24];
#pragma unroll
        for (int j = 0; j < 24; ++j) { const int rr = r0 - 8 + j; v4u z = {0u, 0u, 0u, 0u}; if (rr >= seq_lo && rr < seq_hi) z = *(const v4u*)(PX + (size_t)rr * INW + ch); raw[j] = z; }
        float inv[8];
#pragma unroll
        for (int t = 0; t < 8; ++t) { const int r = r0 + t; inv[t] = 1.f / (float)(min(r + half, seq_hi) - max(r - half, seq_lo)); }
        unsigned outw[8][4];
#pragma unroll
        for (int q = 0; q < 4; ++q) {
            f32x2 f[24];
#pragma unroll
            for (int j = 0; j < 24; ++j) { const unsigned u = raw[j][q]; f[j] = (f32x2){bflo(u), bfhi(u)}; }
#pragma unroll
            for (int t = 0; t < 8; ++t) {
                const f32x2 w1 = f[t + 7] + f[t + 8];
                const f32x2 w2 = w1 + (f[t + 6] + f[t + 9]);
                const f32x2 w4 = w2 + ((f[t + 4] + f[t + 5]) + (f[t + 10] + f[t + 11]));
                const f32x2 w8 = w4 + (((f[t] + f[t + 1]) + (f[t + 2] + f[t + 3])) + ((f[t + 12] + f[t + 13]) + (f[t + 14] + f[t + 15])));
                f32x2 w = g == 0 ? w1 : (g == 1 ? w2 : (g == 2 ? w4 : w8));
                w = w * inv[t] - f[t + 8];
                outw[t][q] = pk2(w.x, w.y);
            }
        }
#pragma unroll
        for (int t = 0; t < 8; ++t) { v4u o; o.x = outw[t][0]; o.y = outw[t][1]; o.z = outw[t][2]; o.w = outw[t][3]; *(v4u*)(A2 + (size_t)(r0 + t) * D + ch) = o; }
    }
}

constexpr int AT_KSB = 128 * 144, AT_VROW = 264, AT_BUF = AT_KSB + 64 * AT_VROW;
constexpr int NQB = 1;
DI void attn_unit(LAS unsigned char* lds, const bf16* PX, bf16* A2, const float* sink, int qrow0, int kvh, int hp, int ctxrow0, int xrow0, int nblk  ) {
    const int tid = threadIdx.x, lane = tid & 63, wave = __builtin_amdgcn_readfirstlane(tid >> 6);
    const int g = hp * (2 * NQB) + wave / (4 / NQB), qoff = (wave % (4 / NQB)) * 32 * NQB, hq = 4 * kvh + g, r = lane & 31, h = lane >> 5;
    const int nch = nblk < 0 ? 2 : 3 + (nblk > 0) + (nblk < 15);
    bf16x8 qf[NQB][4];
#pragma unroll
    for (int qb = 0; qb < NQB; ++qb)
#pragma unroll
        for (int ks = 0; ks < 4; ++ks) qf[qb][ks] = *(const bf16x8*)(PX + (size_t)(qrow0 + qoff + 32 * qb + r) * INW + 512 + 64 * hq + 16 * ks + 8 * h);
    float mrun[NQB], lrun[NQB]; f32x16 O[NQB][2];
    const float sk = sink[hq] * LOG2E;
#pragma unroll
    for (int qb = 0; qb < NQB; ++qb) { mrun[qb] = sk; lrun[qb] = h == 0 ? 1.f : 0.f;
#pragma unroll
        for (int db = 0; db < 2; ++db)
#pragma unroll
            for (int i = 0; i < 16; ++i) O[qb][db][i] = 0.f; }
    v4u kreg[2], vreg[2];
#define AT_ROW(ci) ((ci) < 2 ? ctxrow0 + 128 * (ci) : xrow0 + 128 * (nblk - 1 + ((ci) - 2) + (nblk == 0 ? 1 : 0)))
#define AT_ISSUE(ci) do { const int row_ = AT_ROW(ci); _Pragma("unroll") for (int i_ = 0; i_ < 2; ++i_) { const int p_ = tid + 512 * i_; \
        kreg[i_] = *(const v4u*)(PX + (size_t)(row_ + (p_ >> 3)) * INW + 1024 + 64 * kvh + 8 * (p_ & 7)); \
        vreg[i_] = *(const v4u*)(PX + (size_t)(row_ + (p_ & 127)) * INW + 1152 + 64 * kvh + 8 * (p_ >> 7)); } } while (0)
#define AT_COMMIT(buf) do { LAS unsigned char* b_ = lds + (buf) * AT_BUF; _Pragma("unroll") for (int i_ = 0; i_ < 2; ++i_) { const int p_ = tid + 512 * i_; \
        *(LAS v4u*)(b_ + (p_ >> 3) * 144 + (p_ & 7) * 16) = kreg[i_]; \
        LAS unsigned short* vt_ = (LAS unsigned short*)(b_ + AT_KSB + (8 * (p_ >> 7)) * AT_VROW + (p_ & 127) * 2); const v4u v_ = vreg[i_]; \
        vt_[0] = (unsigned short)v_.x; vt_[AT_VROW / 2] = (unsigned short)(v_.x >> 16); vt_[2 * (AT_VROW / 2)] = (unsigned short)v_.y; vt_[3 * (AT_VROW / 2)] = (unsigned short)(v_.y >> 16); \
        vt_[4 * (AT_VROW / 2)] = (unsigned short)v_.z; vt_[5 * (AT_VROW / 2)] = (unsigned short)(v_.z >> 16); vt_[6 * (AT_VROW / 2)] = (unsigned short)v_.w; vt_[7 * (AT_VROW / 2)] = (unsigned short)(v_.w >> 16); } } while (0)
    AT_ISSUE(0); AT_COMMIT(0); __syncthreads();
#pragma unroll 1
    for (int ci = 0; ci < nch; ++ci) {
        if (ci + 1 < nch) AT_ISSUE(ci + 1);
        int mt = 0; if (ci >= 2) mt = ((ci - 2) + (nblk == 0 ? 1 : 0)) - 1;
        const LAS unsigned char* Kb = lds + (ci & 1) * AT_BUF; const LAS unsigned char* Vb = Kb + AT_KSB;
#pragma unroll 1
        for (int kp = 0; kp < 2; ++kp) {
            static_assert(NQB == 1, "the paired-tile loop is written for one 32-row query block per wave");
            const int qi0 = qoff;
            const bool need = mt == 0 || (mt < 0 ? (64 * kp + 63 >= qi0) : (64 * kp <= qi0 + 31));
            if (!need) continue;
            bf16x8 kf0[4], kf1[4];
#pragma unroll
            for (int ks = 0; ks < 4; ++ks) { kf0[ks] = *(const LAS bf16x8*)(Kb + (64 * kp + r) * 144 + 32 * ks + 16 * h); kf1[ks] = *(const LAS bf16x8*)(Kb + (64 * kp + 32 + r) * 144 + 32 * ks + 16 * h); }
            f32x16 S0, S1;
#pragma unroll
            for (int i = 0; i < 16; ++i) { S0[i] = 0.f; S1[i] = 0.f; }
#pragma unroll
            for (int ks = 0; ks < 4; ++ks) { S0 = __builtin_amdgcn_mfma_f32_32x32x16_bf16(kf0[ks], qf[0][ks], S0, 0, 0, 0); S1 = __builtin_amdgcn_mfma_f32_32x32x16_bf16(kf1[ks], qf[0][ks], S1, 0, 0, 0); }
            bf16x8 vf[2][4];
#pragma unroll
            for (int db = 0; db < 2; ++db)
#pragma unroll
                for (int s = 0; s < 4; ++s) { const LAS unsigned char* vp = Vb + (32 * db + r) * AT_VROW + (64 * kp + 16 * s + 4 * h) * 2;
                    const s16x4 lo = *(const LAS s16x4*)vp, hi = *(const LAS s16x4*)(vp + 16); vf[db][s] = __builtin_shufflevector(lo, hi, 0, 1, 2, 3, 4, 5, 6, 7); }
            if (mt != 0) { const int dq = (qi0 + r - 64 * kp - 4 * h) * mt;
#pragma unroll
                for (int i = 0; i < 16; ++i) { const int d0 = dq - ((i & 3) + 8 * (i >> 2)) * mt, d1 = d0 - 32 * mt; S0[i] = d0 >= 0 ? S0[i] : -1e30f; S1[i] = d1 >= 0 ? S1[i] : -1e30f; } }
            float mx = fmaxf(S0[0], S1[0]);
#pragma unroll
            for (int i = 1; i < 16; ++i) mx = fmaxf(mx, fmaxf(S0[i], S1[i]));
            mx = fmaxf(mx, __shfl_xor(mx, 32));
            const float mn = fmaxf(mrun[0], mx);
            if (__builtin_amdgcn_ballot_w64(mn != mrun[0]) != 0ull) {
                const float alpha = __builtin_amdgcn_exp2f(mrun[0] - mn); mrun[0] = mn; lrun[0] *= alpha;
#pragma unroll
                for (int db = 0; db < 2; ++db)
#pragma unroll
                    for (int i = 0; i < 16; ++i) O[0][db][i] *= alpha;
            }
            float ps0 = 0.f, ps1 = 0.f;
#pragma unroll
            for (int i = 0; i < 16; ++i) { S0[i] = __builtin_amdgcn_exp2f(S0[i] - mn); S1[i] = __builtin_amdgcn_exp2f(S1[i] - mn); ps0 += S0[i]; ps1 += S1[i]; }
            lrun[0] += ps0 + ps1;
            bf16x8 pf[4];
#pragma unroll
            for (int s = 0; s < 2; ++s) { v4u p; p.x = pk2(S0[8 * s], S0[8 * s + 1]); p.y = pk2(S0[8 * s + 2], S0[8 * s + 3]); p.z = pk2(S0[8 * s + 4], S0[8 * s + 5]); p.w = pk2(S0[8 * s + 6], S0[8 * s + 7]); pf[s] = __builtin_bit_cast(bf16x8, p);
                v4u q; q.x = pk2(S1[8 * s], S1[8 * s + 1]); q.y = pk2(S1[8 * s + 2], S1[8 * s + 3]); q.z = pk2(S1[8 * s + 4], S1[8 * s + 5]); q.w = pk2(S1[8 * s + 6], S1[8 * s + 7]); pf[2 + s] = __builtin_bit_cast(bf16x8, q); }
#pragma unroll
            for (int s = 0; s < 4; ++s)
#pragma unroll
                for (int db = 0; db < 2; ++db) O[0][db] = __builtin_amdgcn_mfma_f32_32x32x16_bf16(vf[db][s], pf[s], O[0][db], 0, 0, 0);
        }
        if (ci + 1 < nch) AT_COMMIT((ci + 1) & 1);
        __syncthreads();
    }
#pragma unroll
    for (int qb = 0; qb < NQB; ++qb) {
        const float lt = lrun[qb] + __shfl_xor(lrun[qb], 32), inv = 1.f / lt;
        bf16* orow = A2 + (size_t)(qrow0 + qoff + 32 * qb + r) * D + 512 + 64 * hq;
#pragma unroll
        for (int db = 0; db < 2; ++db)
#pragma unroll
            for (int gq = 0; gq < 4; ++gq) { v2u o; o.x = pk2(O[qb][db][4 * gq] * inv, O[qb][db][4 * gq + 1] * inv); o.y = pk2(O[qb][db][4 * gq + 2] * inv, O[qb][db][4 * gq + 3] * inv);
                *(v2u*)(orow + 32 * db + 8 * gq + 4 * h) = o; }
    }
#undef AT_ROW
#undef AT_ISSUE
#undef AT_COMMIT
}
DI void phase_attn(const Args& a, LAS unsigned char* lds, int G, int layer_i, bool with_ctx) {
    const bf16* PX = (const bf16*)(a.ws + WS_PX); bf16* A2 = (bf16*)(a.ws + WS_A2);
    const float* sink = a.in[11] + layer_i * 8;
    constexpr int UPB = 2 / NQB;
    const int nunits = (256 + (with_ctx ? 32 : 0)) * UPB;
    if (NQB == 1 && (G & 7) == 0) {
        const int b = blockIdx.x & 7, per = 64 + (with_ctx ? 8 : 0);
        for (int hl = blockIdx.x >> 3; hl < per; hl += G >> 3) {
            if (hl < 64) { const int kvh = hl >> 5, n = (hl >> 1) & 15, hp = hl & 1; attn_unit(lds, PX, A2, sink, b * SEQ + 128 * n, kvh, hp, TX + b * CTXL, b * SEQ, n); }
            else { const int hc = hl - 64, kvh = hc >> 2, cn = (hc >> 1) & 1, hp = hc & 1; attn_unit(lds, PX, A2, sink, TX + b * CTXL + 128 * cn, kvh, hp, TX + b * CTXL, 0, -1); }
        }
        return;
    }
    for (int uu = blockIdx.x; uu < nunits; uu += G) {
        const int u = uu / UPB, hp = uu % UPB;
        if (u < 256) { const int b = u >> 5, kvh = (u >> 4) & 1, n = u & 15; attn_unit(lds, PX, A2, sink, b * SEQ + 128 * n, kvh, hp, TX + b * CTXL, b * SEQ, n); }
        else { const int v = u - 256, b = v >> 2, kvh = (v >> 1) & 1, cn = v & 1; attn_unit(lds, PX, A2, sink, TX + b * CTXL + 128 * cn, kvh, hp, TX + b * CTXL, 0, -1); }
    }
}

constexpr int CT = 16;
DI void phase_conv(const Args& a, LAS unsigned char* lds, int G, int li, int nrows) {
    const int tid = threadIdx.x, ch = 2 * tid;
    const bf16* Gb = (const bf16*)(a.ws + WS_PX); bf16* Y = (bf16*)(a.ws + WS_A2);
    f32x2 wv[31];
#pragma unroll
    for (int k = 0; k < 31; ++k) wv[k] = *(const f32x2*)(a.in[14] + ((size_t)li * 31 + k) * D + ch);
    const f32x2 bias = *(const f32x2*)(a.in[15] + li * D + ch), lg = *(const f32x2*)(a.in[16] + li * D + ch), lb = *(const f32x2*)(a.in[17] + li * D + ch);
    LAS f32x2* red = (LAS f32x2*)lds;
    LAS f32x2* stats = (LAS f32x2*)(lds + 131072);
    const int ntiles = nrows / CT;
#pragma unroll 1
    for (int slot = blockIdx.x; slot < ntiles; slot += G) {
        const int tile = ((G & 7) == 0 && (ntiles & 7) == 0) ? (slot & 7) * (ntiles >> 3) + (slot >> 3) : slot;
        const int r0 = tile * CT;
        int lo, hi; if (r0 < TX) { lo = r0 & ~(SEQ - 1); hi = lo + SEQ; } else { lo = TX + ((r0 - TX) & ~(CTXL - 1)); hi = lo + CTXL; }
        f32x2 v[CT + 30];
#pragma unroll
        for (int j = 0; j < CT + 30; ++j) { const int rr = r0 - 15 + j; unsigned u = 0u; if (rr >= lo && rr < hi) u = *(const unsigned*)(Gb + (size_t)rr * D + ch); v[j].x = bflo(u); v[j].y = bfhi(u); }
        f32x2 acc[CT];
#pragma unroll
        for (int t = 0; t < CT; ++t) { acc[t] = bias;
#pragma unroll
            for (int k = 0; k < 31; ++k) acc[t] += wv[k] * v[t + k]; }
#pragma unroll
        for (int t = 0; t < CT; ++t) { f32x2 sq; sq.x = acc[t].x + acc[t].y; sq.y = acc[t].x * acc[t].x + acc[t].y * acc[t].y; red[t * 512 + tid] = sq; }
        __syncthreads();
        { const int t = tid >> 5, p = tid & 31; f32x2 s = {0.f, 0.f};
#pragma unroll
            for (int e = 0; e < 16; ++e) s += red[t * 512 + p + 32 * e];
#pragma unroll
            for (int o = 1; o < 32; o <<= 1) { s.x += __shfl_xor(s.x, o); s.y += __shfl_xor(s.y, o); }
            if (p == 0) { const float mean = s.x * (1.f / D), var = fmaxf(s.y * (1.f / D) - mean * mean, 0.f); f32x2 st; st.x = mean; st.y = 1.f / sqrtf(var + NORM_EPS); stats[t] = st; } }
        __syncthreads();
#pragma unroll
        for (int t = 0; t < CT; ++t) { const f32x2 st = stats[t]; f32x2 y = (acc[t] - st.x) * st.y * lg + lb;
            y.x = y.x * __builtin_amdgcn_rcpf(1.f + __expf(-y.x)); y.y = y.y * __builtin_amdgcn_rcpf(1.f + __expf(-y.y));
            *(unsigned*)(Y + (size_t)(r0 + t) * D + ch) = pk2(y.x, y.y); }
    }
}

struct OrderX : pg8::StaticOrder {
    int nextra;
    __device__ __forceinline__ bool next(int i, pg8::Unit& u) const {
        const long Lx = (long)i * G + c; const bool inmain = Lx < nwg;
        pg8::Unit m; m.pm = 0; m.pn = 0; m.kb = 0; m.nt = ntf;
        if (inmain) pg8::StaticOrder::next(i, m);
        const int e = (int)(Lx - nwg);
        u.pm = inmain ? m.pm : 64 + e; u.pn = inmain ? m.pn : 4; u.kb = 0; u.nt = ntf;
        return inmain || e < nextra; }
};
struct OrderSplit : pg8::StaticOrder {
    int nsplit;
    __device__ __forceinline__ bool next(int i, pg8::Unit& u) const {
        const long Lx = (long)i * G + c; const bool inmain = Lx < nwg;
        pg8::Unit m; m.pm = 0; m.pn = 0; m.kb = 0; m.nt = ntf;
        if (inmain) pg8::StaticOrder::next(i, m);
        const int e = (int)(Lx - nwg), ns = nsplit > 0 ? nsplit : 1, t = e / ns, ks = e - t * ns, nts = ntf / ns;
        u.pm = inmain ? m.pm : 64 + (t >> 2); u.pn = inmain ? m.pn : (t & 3); u.nt = inmain ? ntf : nts; u.kb = inmain ? 0 : ks * nts * 128;
        return inmain || e < 32 * nsplit; }
};

#define XB_TMO      128
#define XB_XCNT(j)  (256  + 64 * (j))
#define XB_XSUB(j)  (1280 + 64 * (j))
#define XB_XGEN(j)  (2304 + 64 * (j))
#define XB_TOP      3328
#define XB_TOPGEN   3392
#define XCD_BAR_WORDS 3456
#define XB_SPIN_CAP (1u << 18)

__device__ __forceinline__ unsigned xb_ld(unsigned* p)              { return __hip_atomic_load(p, __ATOMIC_RELAXED, __HIP_MEMORY_SCOPE_AGENT); }
__device__ __forceinline__ unsigned xb_add(unsigned* p, unsigned v) { return __hip_atomic_fetch_add(p, v, __ATOMIC_RELAXED, __HIP_MEMORY_SCOPE_AGENT); }
__device__ __forceinline__ unsigned xb_xcc_id() { return (unsigned)__builtin_amdgcn_s_getreg((3 << 11) | 20) & 0xFu; }
#define XB_SPIN(cond, bar) do { unsigned _sp = 0; while (cond) { __builtin_amdgcn_s_sleep(1); \
    if ((++_sp & 255u) == 0u) { if (xb_ld(&(bar)[XB_TMO])) break; if (_sp > XB_SPIN_CAP) { atomicAdd(&(bar)[XB_TMO], 1u); break; } } } } while (0)

struct XcdBarrier {
    unsigned* bar; unsigned x;
    volatile LAS unsigned* st;
};

__device__ __forceinline__ XcdBarrier xcd_barrier_post(unsigned* bar, volatile LAS unsigned* st) {
    XcdBarrier b; b.bar = bar; b.x = xb_xcc_id(); b.st = st;
    if (threadIdx.x == 0) (void)xb_add(&bar[XB_XCNT(b.x)], 1u);
    return b;
}
__device__ __forceinline__ void xcd_barrier_complete(unsigned* bar, unsigned x, unsigned& nloc, unsigned& nx) {
    const unsigned G = gridDim.x * gridDim.y * gridDim.z;
    unsigned sum, cnt, mine, sp = 0u;
    for (;;) {
        sum = 0u; cnt = 0u; mine = 0u;
#pragma unroll
        for (unsigned j = 0; j < 16; ++j) { const unsigned c = xb_ld(&bar[XB_XCNT(j)]); sum += c; cnt += (c > 0u) ? 1u : 0u; mine = (j == x) ? c : mine; }
        if (sum == G) break;
        __builtin_amdgcn_s_sleep(1);
        if ((++sp & 255u) == 0u) { if (xb_ld(&bar[XB_TMO])) break; if (sp > XB_SPIN_CAP) { atomicAdd(&bar[XB_TMO], 1u); break; } }
    }
    nloc = mine > 0u ? mine : 1u; nx = cnt > 0u ? cnt : 1u;
}

__device__ __forceinline__ void xcd_barrier(const XcdBarrier& b, bool wb = true) {
    asm volatile("s_waitcnt vmcnt(0)" ::: "memory");
    __syncthreads();
    if (threadIdx.x == 0) {
        unsigned* bar = b.bar;
        __builtin_amdgcn_s_waitcnt(0);
        unsigned nloc = b.st[0], nx = b.st[1];
        if (nloc == 0u) { xcd_barrier_complete(bar, b.x, nloc, nx); b.st[0] = nloc; b.st[1] = nx; }
        const unsigned old = xb_add(&bar[XB_XSUB(b.x)], 1u);
        const unsigned gen = old / nloc;
        if (old + 1u == (gen + 1u) * nloc) {
            if (wb) __builtin_amdgcn_fence(__ATOMIC_RELEASE, "agent");
            asm volatile("s_waitcnt vmcnt(0)" ::: "memory");
            if (wb) {
            const unsigned og = xb_add(&bar[XB_TOP], 1u);
            const unsigned tg = og / nx;
            if (og + 1u == (tg + 1u) * nx) xb_add(&bar[XB_TOPGEN], 1u);
            else XB_SPIN(xb_ld(&bar[XB_TOPGEN]) == tg, bar);
            }
            __builtin_amdgcn_fence(__ATOMIC_ACQUIRE, "agent");
            xb_add(&bar[XB_XGEN(b.x)], 1u);
            asm volatile("s_waitcnt vmcnt(0)" ::: "memory");
        } else {
            XB_SPIN(xb_ld(&bar[XB_XGEN(b.x)]) == gen, bar);
            __builtin_amdgcn_fence(__ATOMIC_ACQUIRE, "agent");
            asm volatile("s_waitcnt vmcnt(0)" ::: "memory");
        }
    }
    __syncthreads();
}
#define IN(k) (lo <= (k) && (k) < hi)
#ifndef REP_SYNC
#define REP_SYNC 1
#endif
#ifndef REP_W1
#define REP_W1 1
#endif
#ifndef REP_RES
#define REP_RES 1
#endif
#ifndef REP_ATTN
#define REP_ATTN 1
#endif
#ifndef REP_POOL
#define REP_POOL 1
#endif
#ifndef REP_CONV
#define REP_CONV 1
#endif
#ifndef REP_NORM
#define REP_NORM 1
#endif
#ifndef REP_PREP
#define REP_PREP 1
#endif
#define SEAM(k) do { if (IN(k) && IN((k) + 1)) { for (int r_ = 0; r_ < REP_SYNC; ++r_) { xcd_barrier(xb); } } } while (0)
#define SEAM_L(k) do { if (IN(k) && IN((k) + 1)) xcd_barrier(xb, !regular); } while (0)
#define SEAM_X(k) do { if (l >= 2) SEAM_L(k); else SEAM(k); } while (0)
template <int l> DI void layer_fwd(const Args& a, LAS unsigned char* lds, cg::grid_group& grid, const XcdBarrier& xb, int G, int lo, int hi, bool regular) {
    unsigned char* ws = a.ws;
    float* X = (float*)(ws + WS_X); bf16* H = (bf16*)(ws + WS_H); bf16* PX = (bf16*)(ws + WS_PX); bf16* A2 = (bf16*)(ws + WS_A2); bf16* HB = (bf16*)(ws + WS_HID);
    const float* MOD = (const float*)(ws + WS_MOD); float* RSS = (float*)(ws + WS_RSS); const float* SHW = (const float*)(ws + WS_SHW); float* PART = (float*)(ws + WS_PART);
    constexpr int p0 = 1 + 7 * l, li = l >> 1;
    const float* modl = MOD + (size_t)l * 9 * 6144;
    constexpr int Mrows = l < 2 ? TT : TX;
    const pg8::RowScale R0{RSS, SHW + (size_t)(l * 2 + 0) * 9 * 4096}, R1{RSS, SHW + (size_t)(l * 2 + 1) * 9 * 4096};
    if (l <= 2) {
        if (IN(p0)) { if (l == 0) { for (int pr_ = 0; pr_ < P_L0N; ++pr_) phase_norm<1, 0>(a, G, 0, TT, a.in[6], modl, 1); for (int pr_ = 0; pr_ < P_SHW; ++pr_) phase_shw(a, G); } else phase_norm<0, 8>(a, G, TX, TT, a.in[6] + l * D, modl, 1); }
        SEAM(p0);
    }
    if ((l & 1) == 0) {
        if (IN(p0 + 1)) { pg8::Gemm g{H, (const bf16*)(ws + WS_WIN) + (size_t)li * INW * D, l == 0 ? TT : TX, INW, D};
            OrderX S; S.init(g.M, INW, G, (int)blockIdx.x, D); S.nextra = l == 0 ? 0 : 8;
            pg8::EpiPX E{PX, (const float*)(ws + WS_TAB), 0.125f * LOG2E, R0};
            pg8::gemm_phase<pg8::EpiPX, OrderX, true, true>(lds, g, S, E); }
        SEAM_X(p0 + 1);
        if (IN(p0 + 2)) {
            for (int r_ = 0; r_ < REP_ATTN; ++r_) phase_attn(a, lds, G, li, l == 0);
            for (int r_ = 0; r_ < REP_POOL; ++r_) phase_pool(a, G, Mrows); }
        SEAM_X(p0 + 2);
        if (IN(p0 + 3)) { pg8::Gemm g{A2, (const bf16*)(ws + WS_WOUT) + (size_t)li * D * D, Mrows, D, D};
            OrderSplit S; S.init(TX, D, G, (int)blockIdx.x, D); S.nsplit = l < 2 ? 4 : 0;
            pg8::EpiRes<true> E{X, modl, 2 * 1024, D / 64, PART, a.in[7] + l * D, modl + 4 * 1024, H, RSS, l == 0 ? a.in[0] : (const float*)X};
#if REP_RES > 1
            { pg8::EpiRes<true> E0{X, (const float*)(ws + WS_ZERO), 0, D / 64, PART, a.in[7] + l * D, modl + 4 * 1024, H, RSS}; pg8::gemm_phase<pg8::EpiRes<true>, OrderSplit, true, true>(lds, g, S, E0); }
#endif
            pg8::gemm_phase<pg8::EpiRes<true>, OrderSplit, true, true>(lds, g, S, E); }
        SEAM(p0 + 3);
    } else {
        if (IN(p0 + 1)) { pg8::Gemm g{H, (const bf16*)(ws + WS_PW1) + (size_t)li * 2048 * D, Mrows, 2048, D};
            pg8::StaticOrder S; S.init(Mrows, 2048, G, (int)blockIdx.x, D);
            pg8::EpiGLU E{PX, R0};
            pg8::gemm_phase<pg8::EpiGLU, pg8::StaticOrder, true, true>(lds, g, S, E); }
        SEAM_X(p0 + 1);
        if (IN(p0 + 2)) { for (int r_ = 0; r_ < REP_CONV; ++r_) { phase_conv(a, lds, G, li, Mrows); __syncthreads(); } }
        SEAM_X(p0 + 2);
        if (IN(p0 + 3)) { pg8::Gemm g{A2, (const bf16*)(ws + WS_PW2) + (size_t)li * D * D, Mrows, D, D};
            OrderSplit S; S.init(TX, D, G, (int)blockIdx.x, D); S.nsplit = l < 2 ? 4 : 0;
            pg8::EpiRes<true> E{X, modl, 2 * 1024, D / 64, PART, a.in[7] + l * D, modl + 4 * 1024, H, RSS, l == 0 ? a.in[0] : (const float*)X};
#if REP_RES > 1
            { pg8::EpiRes<true> E0{X, (const float*)(ws + WS_ZERO), 0, D / 64, PART, a.in[7] + l * D, modl + 4 * 1024, H, RSS}; pg8::gemm_phase<pg8::EpiRes<true>, OrderSplit, true, true>(lds, g, S, E0); }
#endif
            pg8::gemm_phase<pg8::EpiRes<true>, OrderSplit, true, true>(lds, g, S, E); }
        SEAM(p0 + 3);
    }
    if (l < 2) {
        if (IN(p0 + 4)) phase_norm<(l == 0 ? 2 : 0), 4>(a, G, TX, TT, a.in[7] + l * D, modl, 4);
        SEAM(p0 + 4);
    }
    if (IN(p0 + 5)) { pg8::Gemm g{H, (const bf16*)(ws + WS_W1) + (size_t)l * D * HIDN, Mrows, HIDN, D};
        pg8::StaticOrder S; S.init(Mrows, HIDN, G, (int)blockIdx.x, D);
        pg8::EpiSq E{HB, R1};
        pg8::gemm_phase<pg8::EpiSq, pg8::StaticOrder, true, true>(lds, g, S, E);
#if REP_W1 > 1
        pg8::gemm_phase<pg8::EpiSq, pg8::StaticOrder, true, true>(lds, g, S, E);
#endif
        }
    SEAM_X(p0 + 5);
    if (IN(p0 + 6)) { pg8::Gemm g{HB, (const bf16*)(ws + WS_W2) + (size_t)l * D * HIDN, Mrows, D, HIDN};
        OrderSplit S; S.init(TX, D, G, (int)blockIdx.x, HIDN); S.nsplit = l < 2 ? 8 : 0;
        constexpr int ln = l < 3 ? l + 1 : 3;
        pg8::EpiRes<(l < 3)> E{X, modl, 5 * 1024, HIDN / 64, PART, a.in[6] + ln * D, MOD + (size_t)ln * 9 * 6144 + 1 * 1024, H, RSS, X};
#if REP_RES > 1
        { pg8::EpiRes<(l < 3)> E0{X, (const float*)(ws + WS_ZERO), 0, HIDN / 64, PART, a.in[6] + ln * D, MOD + (size_t)ln * 9 * 6144 + 1 * 1024, H, RSS}; pg8::gemm_phase<pg8::EpiRes<(l < 3)>, OrderSplit, true, true>(lds, g, S, E0); }
#endif
        pg8::gemm_phase<pg8::EpiRes<(l < 3)>, OrderSplit, true, true>(lds, g, S, E); }
    if (l == 3) SEAM_L(p0 + 6); else SEAM(p0 + 6);
}
__global__ void __launch_bounds__(512, 2) mega_fwd(Args a) {
    extern __shared__ __attribute__((aligned(16))) unsigned char lds_raw[];
    LAS unsigned char* lds = (LAS unsigned char*)lds_raw;
    const int G = gridDim.x, lo = a.ph_lo, hi = a.ph_hi;
    cg::grid_group grid = cg::this_grid();
    volatile LAS unsigned* xst = (volatile LAS unsigned*)(lds + LDS_BYTES - 64);
    if (threadIdx.x == 0) { xst[0] = 0u; xst[1] = 0u; }
    __syncthreads();
    XcdBarrier xb = xcd_barrier_post((unsigned*)(a.ws + WS_BAR), xst);
    unsigned* xid = (unsigned*)(a.ws + WS_ZERO);
    if (threadIdx.x == 0) xid[blockIdx.x] = xb.x;
    if (a.ph_hi < 0) grid.sync();
    unsigned char* ws = a.ws;
    float* X = (float*)(ws + WS_X); bf16* H = (bf16*)(ws + WS_H); bf16* PX = (bf16*)(ws + WS_PX); bf16* A2 = (bf16*)(ws + WS_A2); bf16* HB = (bf16*)(ws + WS_HID);
    const float* MOD = (const float*)(ws + WS_MOD);
    if (IN(0)) { for (int r_ = 0; r_ < REP_PREP; ++r_) { phase_prep(a, lds, G); __syncthreads(); } }
    SEAM(0);
    bool regular = false;
    if (IN(0) && IN(1)) {
        int ok = ((G & 7) == 0) ? 1 : 0;
        for (int t = threadIdx.x; t < G; t += 512) ok &= (xid[t] == xid[t & 7]) ? 1 : 0;
        if (threadIdx.x < 8) for (int k = 0; k < (int)threadIdx.x; ++k) ok &= (xid[threadIdx.x] != xid[k]) ? 1 : 0;
        regular = __syncthreads_and(ok) != 0;
    }
    layer_fwd<0>(a, lds, grid, xb, G, lo, hi, false); layer_fwd<1>(a, lds, grid, xb, G, lo, hi, false); layer_fwd<2>(a, lds, grid, xb, G, lo, hi, regular); layer_fwd<3>(a, lds, grid, xb, G, lo, hi, regular);
    if (IN(29)) { for (int pr_ = 0; pr_ < P_FIN; ++pr_) phase_final(a, G); }
#undef IN
#undef SEAM
}

extern "C" void kernel_launch(void* const* d_in, const int* in_sizes, int n_in, void* d_out, int out_size, void* d_ws, size_t ws_size, hipStream_t stream) {
    static int grid = 0;
    if (grid == 0) {
        if (n_in != 22 || in_sizes[0] != TX * D || out_size != TX * D || ws_size < WS_END) { fprintf(stderr, "kernel_launch: unexpected shapes (n_in %d, in0 %d, out %d, ws %zu)\n", n_in, n_in > 0 ? in_sizes[0] : -1, out_size, ws_size); grid = -1; return; }
        int dev = 0, cus = 0, per_cu = 0;
        if (hipGetDevice(&dev) != hipSuccess || hipDeviceGetAttribute(&cus, hipDeviceAttributeMultiprocessorCount, dev) != hipSuccess) { grid = -1; return; }
        if (hipFuncSetAttribute((const void*)mega_fwd, hipFuncAttributeMaxDynamicSharedMemorySize, LDS_BYTES) != hipSuccess) { fprintf(stderr, "kernel_launch: hipFuncSetAttribute failed\n"); grid = -1; return; }
        if (hipOccupancyMaxActiveBlocksPerMultiprocessor(&per_cu, (const void*)mega_fwd, 512, LDS_BYTES) != hipSuccess || per_cu < 1) { fprintf(stderr, "kernel_launch: occupancy query says %d blocks per CU\n", per_cu); (void)hipGetLastError(); per_cu = 1; }
        grid = cus * 1;
    }
    if (grid < 0) return;
    Args a{};
    for (int i = 0; i < 22; ++i) a.in[i] = (const float*)d_in[i];
    a.out = (float*)d_out; a.ws = (unsigned char*)d_ws;
#if MK_COOP
    if (hipMemsetAsync((char*)d_ws + WS_BAR, 0, BAR_BYTES + (REP_RES > 1 ? 9 * 6144 * 4 : 0), stream) != hipSuccess) { fprintf(stderr, "kernel_launch: memset failed\n"); return; }
    a.ph_lo = 0; a.ph_hi = NPHASE;
    void* args[] = {&a};
    hipError_t e = hipLaunchCooperativeKernel((const void*)mega_fwd, dim3(grid), dim3(512), args, LDS_BYTES, stream);
    if (e != hipSuccess) fprintf(stderr, "kernel_launch: cooperative launch failed: %s (grid %d)\n", hipGetErrorString(e), grid);
#else
    for (int p = 0; p < NPHASE; ++p) { a.ph_lo = p; a.ph_hi = p + 1; hipLaunchKernelGGL(mega_fwd, dim3(grid), dim3(512), LDS_BYTES, stream, a); }
#endif
}
```

```cpp
#ifndef P_MOD
#define P_MOD 1
#endif
#ifndef P_TR
#define P_TR 1
#endif
#ifndef P_FOLD
#define P_FOLD 1
#endif
#ifndef P_SHW
#define P_SHW 1
#endif
#ifndef P_FIN
#define P_FIN 1
#endif
#ifndef P_L0N
#define P_L0N 1
#endif
#include <hip/hip_runtime.h>
#include <hip/hip_cooperative_groups.h>
#include <cstdio>
#include <cstdint>
namespace cg = cooperative_groups;
namespace pg8 {
#define PG8_LAS __attribute__((address_space(3)))
typedef unsigned short bf16_t;
typedef short bf16x8 __attribute__((ext_vector_type(8)));
typedef float f32x4 __attribute__((ext_vector_type(4)));
typedef unsigned u32x4 __attribute__((ext_vector_type(4)));
constexpr int BM = 256, BK = 64, HALF = 128, HTB = HALF * BK * 2  , STAGE_BYTES = 8 * HTB, NXCD = 8, WGM = 8;

__host__ __device__ __forceinline__ int lds_byte(int r, int c) { const int st = (r >> 4) * 2 + (c >> 5), rr = r & 15, cc = c & 31, ob = rr * 64 + cc * 2; return st * 1024 + (ob ^ (((ob >> 9) & 1) << 5)); }
__host__ __device__ __forceinline__ void stage_rc(int b, int& R, int& C) { const int st = b / 1024, sb = b % 1024, swz = sb ^ (((sb >> 9) & 1) << 5); R = (st >> 1) * 16 + swz / 64; C = (st & 1) * 32 + (swz % 64) / 2; }
__host__ __device__ __forceinline__ int perm32(int rho) { const int n = rho >> 4, i = rho & 15; return 8 * (i >> 2) + 4 * n + (i & 3); }

struct Unit { int pm, pn, kb, nt; };
struct Gemm { const bf16_t* A; const bf16_t* Bt; int M, N, K; };

struct StaticOrder {
    int nM, nN, nwg, G, c, ntf;
    __host__ __device__ void init(int M, int N, int G_, int c_, int K_) { nM = M / BM; nN = N / BM; nwg = nM * nN; G = G_; c = c_; ntf = K_ / BK; }
    __host__ __device__ bool next(int i, Unit& u) const {
        const long L = (long)i * G + c; if (L >= nwg) return false;
        int wgid = (int)L; { const int q = nwg / NXCD, r = nwg % NXCD, xcd = wgid % NXCD, off = wgid / NXCD; wgid = (xcd < r ? xcd * (q + 1) : r * (q + 1) + (xcd - r) * q) + off; }
        const int nig = WGM * nN, gid = wgid / nig, fm = gid * WGM, gsz = (nM - fm) < WGM ? (nM - fm) : WGM;
        u.pm = fm + ((wgid % nig) % gsz); u.pn = (wgid % nig) / gsz; u.kb = 0; u.nt = ntf; return true;
    }
    __device__ __forceinline__ void a_ready(const Unit&) const {}
    __device__ __forceinline__ void done(const Unit&) const {}
};

__device__ __forceinline__ unsigned cvt_pk_bf16(float lo, float hi) { unsigned r; asm volatile("v_cvt_pk_bf16_f32 %0, %1, %2" : "=v"(r) : "v"(lo), "v"(hi)); return r; }

struct RowScale {
    const float* RSS;
    const float* shw;
    __device__ __forceinline__ void load(const Unit& u, int wr, int wc, int fr, int fq, float (&rs)[2][4], f32x4 (&b)[2][2]) const {
        const int j = u.pm < 64 ? (u.pm >> 3) : 8, row0 = u.pm * BM + wr * 64 + fr;
#pragma unroll
        for (int ai = 0; ai < 2; ++ai)
#pragma unroll
            for (int m = 0; m < 4; ++m) { const f32x4 t = *(const f32x4*)(RSS + (size_t)(row0 + ai * HALF + m * 16) * 16 + 4 * fq);
                float sm = (t[0] + t[1]) + (t[2] + t[3]); sm += __shfl_xor(sm, 16); sm += __shfl_xor(sm, 32);
                rs[ai][m] = 1.f / sqrtf(sm * (1.f / 1024.f) + 1e-6f); }
        const float* bp = shw + j * 4096 + u.pn * BM + wc * 32 + 8 * fq;
#pragma unroll
        for (int bj = 0; bj < 2; ++bj)
#pragma unroll
            for (int n = 0; n < 2; ++n) b[bj][n] = *(const f32x4*)(bp + bj * HALF + 4 * n);
    }
};
struct EpiPX {
    static constexpr bool PERM = true, AFTER_DRAIN = false;
    bf16_t* O; const float* tab; float qscale; RowScale R;
    __device__ __forceinline__ void operator()(const f32x4 (&acc)[2][2][4][2], const Unit& u, int wr, int wc, int fr, int fq) const {
        const int row0 = u.pm * BM + wr * 64 + fr, col0 = u.pn * BM + wc * 32 + 8 * fq;
        const bool xrows = u.pm < 64, isq = (u.pn == 2 || u.pn == 3);
        const float sc = isq ? qscale : 1.f, sg = (fq & 2) ? 1.f : -1.f;
        float rs[2][4]; f32x4 bb[2][2]; R.load(u, wr, wc, fr, fq, rs, bb);
#pragma unroll
        for (int bj = 0; bj < 2; ++bj) {
            const bool rope = xrows && (isq || (u.pn == 4 && bj == 0));
#pragma unroll
            for (int ai = 0; ai < 2; ++ai)
#pragma unroll
                for (int m = 0; m < 4; ++m) {
                    const int row = row0 + ai * HALF + m * 16;
                    f32x4 v0 = acc[ai][bj][m][0] * rs[ai][m] + bb[bj][0], v1 = acc[ai][bj][m][1] * rs[ai][m] + bb[bj][1];
                    if (rope) {
                        const int s = row & 2047, pos = (wc & 1) ? (s & 63) : (s >> 6);
                        const float* tp = tab + pos * 16 + 8 * (fq & 1);
                        const f32x4 c0 = *(const f32x4*)tp, c1 = *(const f32x4*)(tp + 4), s0 = *(const f32x4*)(tp + 1024), s1 = *(const f32x4*)(tp + 1028);
                        f32x4 p0, p1;
#pragma unroll
                        for (int e = 0; e < 4; ++e) { p0[e] = __shfl_xor(v0[e], 32); p1[e] = __shfl_xor(v1[e], 32); }
                        v0 = v0 * c0 + (p0 * s0) * sg; v1 = v1 * c1 + (p1 * s1) * sg;
                    }
                    v0 = v0 * sc; v1 = v1 * sc;
                    u32x4 w; w.x = cvt_pk_bf16(v0[0], v0[1]); w.y = cvt_pk_bf16(v0[2], v0[3]); w.z = cvt_pk_bf16(v1[0], v1[1]); w.w = cvt_pk_bf16(v1[2], v1[3]);
                    *(u32x4*)(O + (size_t)row * 1280 + col0 + bj * HALF) = w;
                }
        }
    }
};
template <bool NEXT> struct EpiRes {
    static constexpr bool PERM = true, AFTER_DRAIN = false;
    float* X; const float* modl; int goff, ntfull; float* part;
    const float* gn; const float* scn; bf16_t* H; float* RSS;
    const float* Xin;
    __device__ __forceinline__ void operator()(const f32x4 (&acc)[2][2][4][2], const Unit& u, int wr, int wc, int fr, int fq) const {
        const int j = u.pm < 64 ? (u.pm >> 3) : 8;
        const int row0 = u.pm * BM + wr * 64 + fr, col0 = u.pn * BM + wc * 32 + 8 * fq;
        const float* gp = modl + j * 6144 + goff + col0;
        f32x4 gv[2][2];
#pragma unroll
        for (int bj = 0; bj < 2; ++bj)
#pragma unroll
            for (int n = 0; n < 2; ++n) gv[bj][n] = *(const f32x4*)(gp + bj * HALF + n * 4);
        if (u.nt == ntfull) {
        f32x4 mv[2][2];
        if (NEXT) {
#pragma unroll
            for (int bj = 0; bj < 2; ++bj)
#pragma unroll
                for (int n = 0; n < 2; ++n) mv[bj][n] = *(const f32x4*)(gn + col0 + bj * HALF + n * 4) * (*(const f32x4*)(scn + j * 6144 + col0 + bj * HALF + n * 4) + 1.f);
        }
#pragma unroll
        for (int ai = 0; ai < 2; ++ai)
#pragma unroll
            for (int m = 0; m < 4; ++m) { const size_t ro = (size_t)(row0 + ai * HALF + m * 16); float* rowp = X + ro * 1024 + col0; const float* rin = Xin + ro * 1024 + col0; float ss = 0.f;
#pragma unroll
                for (int bj = 0; bj < 2; ++bj) { f32x4 xn[2];
#pragma unroll
                    for (int n = 0; n < 2; ++n) { xn[n] = *(const f32x4*)(rin + bj * HALF + n * 4) + gv[bj][n] * acc[ai][bj][m][n]; *(f32x4*)(rowp + bj * HALF + n * 4) = xn[n]; }
                    if (NEXT) { ss += ((xn[0][0] * xn[0][0] + xn[0][1] * xn[0][1]) + (xn[0][2] * xn[0][2] + xn[0][3] * xn[0][3])) + ((xn[1][0] * xn[1][0] + xn[1][1] * xn[1][1]) + (xn[1][2] * xn[1][2] + xn[1][3] * xn[1][3]));
                        const f32x4 h0 = xn[0] * mv[bj][0], h1 = xn[1] * mv[bj][1];
                        u32x4 w; w.x = cvt_pk_bf16(h0[0], h0[1]); w.y = cvt_pk_bf16(h0[2], h0[3]); w.z = cvt_pk_bf16(h1[0], h1[1]); w.w = cvt_pk_bf16(h1[2], h1[3]);
                        *(u32x4*)(H + ro * 1024 + col0 + bj * HALF) = w; } }
                if (NEXT) { ss += __shfl_xor(ss, 16); ss += __shfl_xor(ss, 32); if (fq == 0) RSS[ro * 16 + u.pn * 4 + wc] = ss; } }
        } else {
        const int ks = u.kb / (u.nt * 128);
        bf16_t* pb = (bf16_t*)part;
#pragma unroll
        for (int ai = 0; ai < 2; ++ai)
#pragma unroll
            for (int m = 0; m < 4; ++m) { bf16_t* rowp = pb + ((size_t)ks * 2048 + (size_t)(row0 - 16384 + ai * HALF + m * 16)) * 1024 + col0;
#pragma unroll
                for (int bj = 0; bj < 2; ++bj) { const f32x4 p0 = gv[bj][0] * acc[ai][bj][m][0], p1 = gv[bj][1] * acc[ai][bj][m][1];
                    u32x4 w; w.x = cvt_pk_bf16(p0[0], p0[1]); w.y = cvt_pk_bf16(p0[2], p0[3]); w.z = cvt_pk_bf16(p1[0], p1[1]); w.w = cvt_pk_bf16(p1[2], p1[3]);
                    *(u32x4*)(rowp + bj * HALF) = w; } }
        }
    }
};
struct EpiSq {
    static constexpr bool PERM = true, AFTER_DRAIN = false;
    bf16_t* O; RowScale R;
    __device__ __forceinline__ void operator()(const f32x4 (&acc)[2][2][4][2], const Unit& u, int wr, int wc, int fr, int fq) const {
        const int row0 = u.pm * BM + wr * 64 + fr, col0 = u.pn * BM + wc * 32 + 8 * fq;
        float rs[2][4]; f32x4 bb[2][2]; R.load(u, wr, wc, fr, fq, rs, bb);
#pragma unroll
        for (int ai = 0; ai < 2; ++ai)
#pragma unroll
            for (int m = 0; m < 4; ++m) { bf16_t* rowp = O + (size_t)(row0 + ai * HALF + m * 16) * 4096 + col0;
#pragma unroll
                for (int bj = 0; bj < 2; ++bj) { f32x4 v0 = acc[ai][bj][m][0] * rs[ai][m] + bb[bj][0], v1 = acc[ai][bj][m][1] * rs[ai][m] + bb[bj][1];
#pragma unroll
                    for (int e = 0; e < 4; ++e) { const float a = fmaxf(v0[e], 0.f), b = fmaxf(v1[e], 0.f); v0[e] = a * a; v1[e] = b * b; }
                    u32x4 w; w.x = cvt_pk_bf16(v0[0], v0[1]); w.y = cvt_pk_bf16(v0[2], v0[3]); w.z = cvt_pk_bf16(v1[0], v1[1]); w.w = cvt_pk_bf16(v1[2], v1[3]);
                    *(u32x4*)(rowp + bj * HALF) = w; } }
    }
};
struct EpiGLU {
    static constexpr bool PERM = true, AFTER_DRAIN = false;
    bf16_t* O; RowScale R;
    __device__ __forceinline__ void operator()(const f32x4 (&acc)[2][2][4][2], const Unit& u, int wr, int wc, int fr, int fq) const {
        const int row0 = u.pm * BM + wr * 64 + fr, col0 = u.pn * HALF + wc * 32 + 8 * fq;
        float rs[2][4]; f32x4 bb[2][2]; R.load(u, wr, wc, fr, fq, rs, bb);
#pragma unroll
        for (int ai = 0; ai < 2; ++ai)
#pragma unroll
            for (int m = 0; m < 4; ++m) {
                f32x4 v[2];
#pragma unroll
                for (int n = 0; n < 2; ++n)
#pragma unroll
                    for (int e = 0; e < 4; ++e) { const float a1 = acc[ai][0][m][n][e] * rs[ai][m] + bb[0][n][e], a2 = acc[ai][1][m][n][e] * rs[ai][m] + bb[1][n][e]; v[n][e] = a1 * __builtin_amdgcn_rcpf(1.f + __expf(-a2)); }
                u32x4 w; w.x = cvt_pk_bf16(v[0][0], v[0][1]); w.y = cvt_pk_bf16(v[0][2], v[0][3]); w.z = cvt_pk_bf16(v[1][0], v[1][1]); w.w = cvt_pk_bf16(v[1][2], v[1][3]);
                *(u32x4*)(O + (size_t)(row0 + ai * HALF + m * 16) * 1024 + col0) = w;
            }
    }
};
template <class Epi, class Sched, bool ALIGN_EPI = false, bool SP2 = false>
__device__ __forceinline__ void gemm_phase(PG8_LAS unsigned char* lds, const Gemm g, const Sched& S, const Epi& E) {
    const int tid = threadIdx.x, wid = __builtin_amdgcn_readfirstlane(tid >> 6), lane = tid & 63, wr = wid >> 2, wc = wid & 3, fr = lane & 15, fq = lane >> 4;
    const int K = g.K;
    unsigned voffA[2], voffB[2];
#pragma unroll
    for (int i = 0; i < 2; ++i) { int R, C; stage_rc(tid * 16 + i * 8192, R, C); const int Rb = Epi::PERM ? ((R & ~31) + perm32(R & 31)) : R;
        voffA[i] = (unsigned)(R * K + C) * 2u; voffB[i] = (unsigned)(Rb * K + C) * 2u; }
    const size_t kstep = (size_t)(BK * 2);
    const size_t hstep = (size_t)HALF * K * 2;
    const size_t tstep = 2 * hstep;
    const unsigned ldsw = (unsigned)wid * 1024u;
    const int aoff = lds_byte(wr * 64 + fr, fq * 8), boff = lds_byte(wc * 32 + fr, fq * 8);
#define PG8_SA(b, h) (((b) * 2 + (h)) * HTB)
#define PG8_SB(b, h) ((4 + (b) * 2 + (h)) * HTB)
#define PG8_STAGE(bufoff, gbase, voff) do { _Pragma("unroll") for (int _i = 0; _i < 2; ++_i) \
        __builtin_amdgcn_global_load_lds((const unsigned*)((const char*)(gbase) + (voff)[_i]), (PG8_LAS unsigned*)(lds + (bufoff) + ldsw + _i * 8192), 16, 0, 0); } while (0)
#define PG8_LDA(dst, b, h) do { _Pragma("unroll") for (int m = 0; m < 4; ++m) _Pragma("unroll") for (int k = 0; k < 2; ++k) dst[m][k] = *(const PG8_LAS bf16x8*)(lds + PG8_SA(b, h) + aoff + m * 2048 + k * 1024); } while (0)
#define PG8_LDB(dst, b, h) do { _Pragma("unroll") for (int n = 0; n < 2; ++n) _Pragma("unroll") for (int k = 0; k < 2; ++k) dst[n][k] = *(const PG8_LAS bf16x8*)(lds + PG8_SB(b, h) + boff + n * 2048 + k * 1024); } while (0)
#define PG8_MMA(ai, bj, At, Bt) do { __builtin_amdgcn_s_setprio(1); _Pragma("unroll") for (int m = 0; m < 4; ++m) _Pragma("unroll") for (int n = 0; n < 2; ++n) _Pragma("unroll") for (int k = 0; k < 2; ++k) \
        acc[ai][bj][m][n] = __builtin_amdgcn_mfma_f32_16x16x32_bf16(Bt[n][k], At[m][k], acc[ai][bj][m][n], 0, 0, 0); __builtin_amdgcn_s_setprio(0); } while (0)
#define PG8_WAIT_V(n) asm volatile("s_waitcnt vmcnt(" #n ")" ::: "memory")
#define PG8_WAIT_L(n) asm volatile("s_waitcnt lgkmcnt(" #n ")" ::: "memory")
#define PG8_BAR __builtin_amdgcn_s_barrier()
#define PG8_SCHED __builtin_amdgcn_sched_barrier(0)
    Unit cur, nxt; int ui = 0;
    if (!S.next(0, cur)) return;
    f32x4 acc[2][2][4][2];
#pragma unroll
    for (int a = 0; a < 2; ++a)
#pragma unroll
        for (int b = 0; b < 2; ++b)
#pragma unroll
            for (int m = 0; m < 4; ++m)
#pragma unroll
                for (int n = 0; n < 2; ++n) acc[a][b][m][n] = (f32x4){0.f, 0.f, 0.f, 0.f};
    bf16x8 At[4][2], B0[2][2], B1[2][2];
    const char* cA = (const char*)g.A + (size_t)cur.pm * tstep + cur.kb; const char* cB = (const char*)g.Bt + (size_t)cur.pn * tstep + cur.kb;
    S.a_ready(cur);
    if constexpr (SP2) {
        PG8_STAGE(PG8_SB(0, 0), cB, voffB); PG8_STAGE(PG8_SB(0, 1), cB + hstep, voffB); PG8_STAGE(PG8_SA(0, 0), cA, voffA); PG8_STAGE(PG8_SA(0, 1), cA + hstep, voffA);
        if (wr == 1) PG8_BAR;
        PG8_WAIT_V(2); PG8_BAR;
        PG8_STAGE(PG8_SB(1, 0), cB + kstep, voffB); PG8_STAGE(PG8_SA(1, 0), cA + kstep, voffA); PG8_STAGE(PG8_SB(1, 1), cB + hstep + kstep, voffB);
        PG8_WAIT_V(6); PG8_BAR;
    } else {
        PG8_STAGE(PG8_SB(0, 0), cB, voffB); PG8_STAGE(PG8_SA(0, 0), cA, voffA); PG8_STAGE(PG8_SB(0, 1), cB + hstep, voffB); PG8_STAGE(PG8_SA(0, 1), cA + hstep, voffA);
        if (wr == 1) PG8_BAR;
        PG8_WAIT_V(4); PG8_BAR;
        PG8_STAGE(PG8_SB(1, 0), cB + kstep, voffB); PG8_STAGE(PG8_SA(1, 0), cA + kstep, voffA); PG8_STAGE(PG8_SB(1, 1), cB + hstep + kstep, voffB);
        PG8_WAIT_V(6); PG8_BAR;
    }
    for (;;) {
        const bool has_next = S.next(ui + 1, nxt);
        const char* nA = has_next ? (const char*)g.A + (size_t)nxt.pm * tstep + nxt.kb : cA; const char* nB = has_next ? (const char*)g.Bt + (size_t)nxt.pn * tstep + nxt.kb : cB;
        const int nt = cur.nt;
        for (int t = 0; t < nt; t += 2) {
            const bool last = (t == nt - 2);
            const char* a1 = cA + (size_t)(t + 1) * kstep;
            const char* a2 = last ? nA : cA + (size_t)(t + 2) * kstep; const char* b2 = last ? nB : cB + (size_t)(t + 2) * kstep;
            const char* a3 = a2 + kstep; const char* b3 = b2 + kstep;
            if (last && has_next) S.a_ready(nxt);
            if constexpr (SP2) {
            PG8_LDB(B0, 0, 0); PG8_LDB(B1, 0, 1); PG8_SCHED; PG8_LDA(At, 0, 0); PG8_STAGE(PG8_SA(1, 1), a1 + hstep, voffA);
            PG8_WAIT_V(8); PG8_WAIT_L(0); PG8_BAR; PG8_MMA(0, 0, At, B0); PG8_MMA(0, 1, At, B1); PG8_BAR; PG8_SCHED;
            PG8_LDA(At, 0, 1); PG8_STAGE(PG8_SB(0, 0), b2, voffB); PG8_STAGE(PG8_SB(0, 1), b2 + hstep, voffB); PG8_STAGE(PG8_SA(0, 0), a2, voffA);
            PG8_WAIT_V(8); PG8_WAIT_L(0); PG8_BAR; PG8_MMA(1, 0, At, B0); PG8_MMA(1, 1, At, B1); PG8_BAR; PG8_SCHED;
            PG8_LDB(B0, 1, 0); PG8_LDB(B1, 1, 1); PG8_SCHED; PG8_LDA(At, 1, 0); PG8_STAGE(PG8_SA(0, 1), a2 + hstep, voffA);
            PG8_WAIT_V(8); PG8_WAIT_L(0); PG8_BAR; PG8_MMA(0, 0, At, B0); PG8_MMA(0, 1, At, B1); PG8_BAR; PG8_SCHED;
            PG8_LDA(At, 1, 1); PG8_STAGE(PG8_SB(1, 0), b3, voffB); PG8_STAGE(PG8_SB(1, 1), b3 + hstep, voffB); PG8_STAGE(PG8_SA(1, 0), a3, voffA);
            PG8_WAIT_V(8); PG8_WAIT_L(0); PG8_BAR; PG8_MMA(1, 0, At, B0); PG8_MMA(1, 1, At, B1); PG8_BAR; PG8_SCHED;
            } else {
            PG8_LDB(B0, 0, 0); PG8_SCHED; PG8_LDA(At, 0, 0); PG8_STAGE(PG8_SA(1, 1), a1 + hstep, voffA);
            PG8_WAIT_L(8); PG8_BAR; PG8_WAIT_L(0); PG8_MMA(0, 0, At, B0); PG8_BAR; PG8_SCHED;
            PG8_LDB(B1, 0, 1); PG8_STAGE(PG8_SB(0, 0), b2, voffB);
            PG8_BAR; PG8_WAIT_L(0); PG8_MMA(0, 1, At, B1); PG8_BAR;
            PG8_LDA(At, 0, 1); PG8_STAGE(PG8_SA(0, 0), a2, voffA);
            PG8_BAR; PG8_WAIT_L(0); PG8_MMA(1, 0, At, B0); PG8_BAR; PG8_SCHED;
            PG8_STAGE(PG8_SB(0, 1), b2 + hstep, voffB);
            PG8_WAIT_V(6); PG8_BAR; PG8_MMA(1, 1, At, B1); PG8_BAR;
            PG8_LDB(B0, 1, 0); PG8_SCHED; PG8_LDA(At, 1, 0); PG8_STAGE(PG8_SA(0, 1), a2 + hstep, voffA);
            PG8_WAIT_L(8); PG8_BAR; PG8_WAIT_L(0); PG8_MMA(0, 0, At, B0); PG8_BAR; PG8_SCHED;
            PG8_LDB(B1, 1, 1); PG8_STAGE(PG8_SB(1, 0), b3, voffB);
            PG8_BAR; PG8_WAIT_L(0); PG8_MMA(0, 1, At, B1); PG8_BAR;
            PG8_LDA(At, 1, 1); PG8_STAGE(PG8_SA(1, 0), a3, voffA);
            PG8_BAR; PG8_WAIT_L(0); PG8_MMA(1, 0, At, B0); PG8_BAR; PG8_SCHED;
            PG8_STAGE(PG8_SB(1, 1), b3 + hstep, voffB);
            PG8_WAIT_V(6); PG8_BAR; PG8_MMA(1, 1, At, B1); PG8_BAR;
            }
        }
        if constexpr (ALIGN_EPI) { if (wr == 0) PG8_BAR; }
        if constexpr (!Epi::AFTER_DRAIN) { E(acc, cur, wr, wc, fr, fq); S.done(cur); }
        if (!has_next) break;
#pragma unroll
        for (int a = 0; a < 2; ++a)
#pragma unroll
            for (int b = 0; b < 2; ++b)
#pragma unroll
                for (int m = 0; m < 4; ++m)
#pragma unroll
                    for (int n = 0; n < 2; ++n) acc[a][b][m][n] = (f32x4){0.f, 0.f, 0.f, 0.f};
        cur = nxt; cA = nA; cB = nB; ++ui;
        if constexpr (ALIGN_EPI) { if (wr == 1) PG8_BAR; }
    }
    PG8_WAIT_V(0);
    if constexpr (!ALIGN_EPI) { if (wr == 0) PG8_BAR; }
    PG8_BAR;
    if constexpr (Epi::AFTER_DRAIN) { E.fused(acc, cur, wr, wc, fr, fq, lds, wid, lane); S.done(cur); }
#undef PG8_SA
#undef PG8_SB
#undef PG8_STAGE
#undef PG8_LDA
#undef PG8_LDB
#undef PG8_MMA
#undef PG8_WAIT_V
#undef PG8_WAIT_L
#undef PG8_BAR
#undef PG8_SCHED
}
}

#ifndef MK_COOP
#define MK_COOP 1
#endif
#define DI __device__ __forceinline__
#define LAS __attribute__((address_space(3)))
typedef unsigned short bf16;
typedef unsigned v4u __attribute__((ext_vector_type(4)));
typedef unsigned v2u __attribute__((ext_vector_type(2)));
typedef float f32x4 __attribute__((ext_vector_type(4)));
typedef float f32x2 __attribute__((ext_vector_type(2)));
typedef float f32x16 __attribute__((ext_vector_type(16)));
typedef short bf16x8 __attribute__((ext_vector_type(8)));
typedef short s16x4 __attribute__((ext_vector_type(4)));
typedef __bf16 bf16v2 __attribute__((ext_vector_type(2)));

constexpr int D = 1024, NB = 8, SEQ = 2048, CTXL = 256, TX = NB * SEQ, TC = NB * CTXL, TT = TX + TC;
constexpr int INW = 1280, HIDN = 4096, NPHASE = 30;
constexpr float NORM_EPS = 1e-6f, LOG2E = 1.4426950408889634f;

constexpr size_t MiB = 1u << 20;
constexpr size_t WS_MOD = 0, WS_TAB = 1 * MiB, WS_BAR = 1 * MiB + 65536, BAR_BYTES = 16384, WS_ZERO = WS_BAR + BAR_BYTES;
constexpr size_t WS_WIN = 2 * MiB, WS_WOUT = 7 * MiB, WS_PW1 = 11 * MiB, WS_PW2 = 19 * MiB, WS_W1 = 23 * MiB, WS_W2 = 55 * MiB;
constexpr size_t WS_X = 88 * MiB, WS_H = 160 * MiB, WS_HID = 196 * MiB, WS_PX = 196 * MiB, WS_A2 = 244 * MiB, WS_PART = 340 * MiB, WS_RSS = 372 * MiB, WS_SHW = 374 * MiB, WS_END = 376 * MiB;
constexpr int LDS_BYTES = 147456;

#define LDS_WAIT() asm volatile("s_waitcnt lgkmcnt(0)" ::: "memory")
DI unsigned f2bf(float f) { unsigned u = __builtin_bit_cast(unsigned, f); return (u + 0x7fffu + ((u >> 16) & 1u)) >> 16; }
DI unsigned pk2(float lo, float hi) { return __builtin_bit_cast(unsigned, __builtin_convertvector((f32x2){lo, hi}, bf16v2)); }
DI float bflo(unsigned u) { return __builtin_bit_cast(float, u << 16); }
DI float bfhi(unsigned u) { return __builtin_bit_cast(float, u & 0xffff0000u); }
DI float wave_sum(float v) {
#pragma unroll
    for (int o = 1; o < 64; o <<= 1) v += __shfl_xor(v, o);
    return v;
}

struct Args { const float* in[22]; float* out; unsigned char* ws; int ph_lo, ph_hi; };

DI int glurow(int n) { return n < 1024 ? 256 * (n >> 7) + (n & 127) : 256 * ((n - 1024) >> 7) + 128 + (n & 127); }
DI void transpose_item(const float* W, int N, int ksrc0, bf16* WT, int Kdst, int kdst0, int nblk, int item, bool glu, LAS float* scr, int lane) {
    const int kb = item / nblk, nb = item % nblk, k0 = 64 * kb, n0 = 32 * nb;
    float tv[32];
#pragma unroll
    for (int i = 0; i < 32; ++i) { const int kk = 2 * i + (lane >> 5); tv[i] = W[(size_t)(ksrc0 + k0 + kk) * N + n0 + (lane & 31)]; }
#pragma unroll
    for (int i = 0; i < 32; ++i) { const int kk = 2 * i + (lane >> 5); scr[kk * 33 + (lane & 31)] = tv[i]; }
    LDS_WAIT(); asm volatile("" ::: "memory");
    const int c = lane & 7;
#pragma unroll
    for (int j = 0; j < 4; ++j) { const int n = (lane >> 3) + 8 * j; const LAS float* s = scr + (8 * c) * 33 + n;
        v4u o; o.x = pk2(s[0 * 33], s[1 * 33]); o.y = pk2(s[2 * 33], s[3 * 33]); o.z = pk2(s[4 * 33], s[5 * 33]); o.w = pk2(s[6 * 33], s[7 * 33]);
        const int ncol = n0 + n, row = glu ? glurow(ncol) : ncol;
        *(v4u*)(WT + (size_t)row * Kdst + kdst0 + k0 + 8 * c) = o; }
    LDS_WAIT(); asm volatile("" ::: "memory");
}
DI void fold_item(const float* pool_w, const float* pool_scale, const float* w_out, bf16* WoutT, int item, int lane) {
    const int rb = item & 7, no = item >> 3, g = rb >> 1, r = 64 * rb + lane, c = r & 127, n0 = 8 * no;
    const float* pw = pool_w + ((size_t)g * 128 + c) * 128; const float* ps = pool_scale + 128 * g; const float* wo = w_out + (size_t)(128 * g) * 1024 + n0;
    f32x4 a0 = {0.f, 0.f, 0.f, 0.f}, a1 = {0.f, 0.f, 0.f, 0.f};
#pragma unroll 4
    for (int d4 = 0; d4 < 32; ++d4) { const f32x4 pv = *(const f32x4*)(pw + 4 * d4);
#pragma unroll
        for (int e = 0; e < 4; ++e) { const int d = 4 * d4 + e; const float p = pv[e] * ps[d]; const f32x4 w0 = *(const f32x4*)(wo + (size_t)d * 1024), w1 = *(const f32x4*)(wo + (size_t)d * 1024 + 4); a0 += w0 * p; a1 += w1 * p; } }
#pragma unroll
    for (int q = 0; q < 4; ++q) { WoutT[(size_t)(n0 + q) * 1024 + r] = (bf16)f2bf(a0[q]); WoutT[(size_t)(n0 + 4 + q) * 1024 + r] = (bf16)f2bf(a1[q]); }
}
DI void phase_prep(const Args& a, LAS unsigned char* lds, int G) {
    const int tid = threadIdx.x, lane = tid & 63, wave = __builtin_amdgcn_readfirstlane(tid >> 6);
    unsigned char* ws = a.ws;
    if (blockIdx.x == (unsigned)(G - 1) && tid < 16) {
        float* tab = (float*)(ws + WS_TAB);
        double theta = 1.0; for (int k = 0; k < tid; ++k) theta *= 0.5623413251903491;
        const double t2 = theta * theta; double c = 1.0, s = theta, tc = 1.0, ts = theta;
        for (int n = 1; n <= 12; ++n) { tc *= -t2 / (double)((2 * n - 1) * (2 * n)); c += tc; ts *= -t2 / (double)((2 * n) * (2 * n + 1)); s += ts; }
        double cc = 1.0, ss = 0.0;
        for (int p = 0; p < 64; ++p) { tab[p * 16 + tid] = (float)cc; tab[1024 + p * 16 + tid] = (float)ss; const double nc = cc * c - ss * s; ss = ss * c + cc * s; cc = nc; }
    }
    if ((int)blockIdx.x < 384) {
        LAS float* st = (LAS float*)lds;
        LAS float* red = (LAS float*)(lds + 36864);
        for (int idx = tid; idx < 9 * 1024; idx += 512) { const int j = idx >> 10, k = idx & 1023; const float v = j < 8 ? a.in[1][j * 1024 + k] : a.in[3][k]; st[idx] = v / (1.f + __expf(-v)); }
        __syncthreads();
        float* MOD = (float*)(ws + WS_MOD);
        for (int pr_ = 0; pr_ < P_MOD; ++pr_)
        for (int it = blockIdx.x; it < 384; it += G) {
            const int l = it / 96, n0 = (it % 96) * 64;
            const float* wp = a.in[4] + ((size_t)l * 1024 + wave * 128) * 6144 + n0 + lane;
            float acc[9];
#pragma unroll
            for (int j = 0; j < 9; ++j) acc[j] = 0.f;
#pragma unroll 8
            for (int k4 = 0; k4 < 32; ++k4) {
                float w[4];
#pragma unroll
                for (int e = 0; e < 4; ++e) w[e] = wp[(size_t)(4 * k4 + e) * 6144];
#pragma unroll
                for (int j = 0; j < 9; ++j) { const f32x4 sv = *(const LAS f32x4*)(st + j * 1024 + wave * 128 + 4 * k4); acc[j] += sv[0] * w[0] + sv[1] * w[1] + sv[2] * w[2] + sv[3] * w[3]; }
            }
#pragma unroll
            for (int j = 0; j < 9; ++j) red[(wave * 9 + j) * 64 + lane] = acc[j];
            __syncthreads();
            for (int idx = tid; idx < 576; idx += 512) { const int j = idx >> 6, ln = idx & 63; float s = a.in[5][l * 6144 + n0 + ln];
#pragma unroll
                for (int w8 = 0; w8 < 8; ++w8) s += red[(w8 * 9 + j) * 64 + ln];
                MOD[((size_t)l * 9 + j) * 6144 + n0 + ln] = s; }
            __syncthreads();
        }
    }
    LAS float* scr = (LAS float*)(lds + 57344 + wave * 8704);
    const int gw = blockIdx.x * 8 + wave, NGW = G * 8;
    bf16* WinT = (bf16*)(ws + WS_WIN); bf16* WoutT = (bf16*)(ws + WS_WOUT); bf16* Pw1T = (bf16*)(ws + WS_PW1); bf16* Pw2T = (bf16*)(ws + WS_PW2); bf16* W1T = (bf16*)(ws + WS_W1); bf16* W2T = (bf16*)(ws + WS_W2);
    constexpr int I_WIN = 16 * 40, I_WOA = 8 * 32, I_PW1 = 16 * 64, I_PW2 = 16 * 32, I_W1 = 16 * 128, I_W2 = 64 * 32;
    constexpr int NITEMS = 2 * I_WIN + 2 * I_WOA + 2 * I_PW1 + 2 * I_PW2 + 4 * I_W1 + 4 * I_W2;
    for (int pr_ = 0; pr_ < P_FOLD; ++pr_)
    for (int it = gw; it < 2048; it += NGW) { const int l = it >> 10; fold_item(a.in[9] + (size_t)l * 4 * 128 * 128, a.in[10] + l * 512, a.in[12] + (size_t)l * D * D, WoutT + (size_t)l * D * D, __builtin_amdgcn_readfirstlane(it & 1023), lane); }
    for (int pr_ = 0; pr_ < P_TR; ++pr_)
    for (int it = gw; it < NITEMS; it += NGW) {
        int r = it;
        if (r < 4 * I_W1) { const int l = r / I_W1; transpose_item(a.in[19] + (size_t)l * D * HIDN, HIDN, 0, W1T + (size_t)l * D * HIDN, D, 0, HIDN / 32, r % I_W1, false, scr, lane); continue; } r -= 4 * I_W1;
        if (r < 4 * I_W2) { const int l = r / I_W2; transpose_item(a.in[20] + (size_t)l * D * HIDN, D, 0, W2T + (size_t)l * D * HIDN, HIDN, 0, D / 32, r % I_W2, false, scr, lane); continue; } r -= 4 * I_W2;
        if (r < 2 * I_WIN) { const int l = r / I_WIN; transpose_item(a.in[8] + (size_t)l * D * INW, INW, 0, WinT + (size_t)l * D * INW, D, 0, INW / 32, r % I_WIN, false, scr, lane); continue; } r -= 2 * I_WIN;
        if (r < 2 * I_WOA) { const int l = r / I_WOA; transpose_item(a.in[12] + (size_t)l * D * D, D, 512, WoutT + (size_t)l * D * D, D, 512, D / 32, r % I_WOA, false, scr, lane); continue; } r -= 2 * I_WOA;
        if (r < 2 * I_PW1) { const int l = r / I_PW1; transpose_item(a.in[13] + (size_t)l * D * 2048, 2048, 0, Pw1T + (size_t)l * D * 2048, D, 0, 2048 / 32, r % I_PW1, true, scr, lane); continue; } r -= 2 * I_PW1;
        { const int l = r / I_PW2; transpose_item(a.in[18] + (size_t)l * D * D, D, 0, Pw2T + (size_t)l * D * D, D, 0, D / 32, r % I_PW2, false, scr, lane); }
    }
}

template <int MODE, int NSPLIT> DI void phase_norm(const Args& a, int G, int rbeg, int rend, const float* gvec, const float* modl, int sci) {
    const int tid = threadIdx.x, lane = tid & 63, wave = tid >> 6, gw = blockIdx.x * 8 + wave, NGW = G * 8;
    float* X = (float*)(a.ws + WS_X); bf16* H = (bf16*)(a.ws + WS_H); float* RSS = (float*)(a.ws + WS_RSS);
#define PN_SRC(r_) (MODE == 1 ? ((r_) < TX ? a.in[0] + (size_t)(r_) * D : a.in[2] + (size_t)((r_) - TX) * D) : (MODE == 2 ? a.in[2] + (size_t)((r_) - TX) * D : X + (size_t)(r_) * D))
    const bool al_ = MODE != 1 && (G & 7) == 0;
    const int rfirst = al_ ? TX + CTXL * ((int)blockIdx.x & 7) + ((int)blockIdx.x >> 3) * 8 + wave : rbeg + gw, rstep = al_ ? (G >> 3) * 8 : NGW, rlim = al_ ? TX + CTXL * ((int)blockIdx.x & 7) + CTXL : rend;
    f32x4 vn[4];
    { const int r = rfirst; if (r < rlim) { const f32x4* s4 = (const f32x4*)PN_SRC(r) + lane;
#pragma unroll
        for (int q = 0; q < 4; ++q) vn[q] = s4[64 * q]; } }
#pragma unroll 1
    for (int r = rfirst; r < rlim; r += rstep) {
        const int j = r < TX ? (r >> 11) : 8;
        f32x4 v[4]; float ss = 0.f;
#pragma unroll
        for (int q = 0; q < 4; ++q) v[q] = vn[q];
        { const int rn = r + rstep; if (rn < rlim) { const f32x4* s4 = (const f32x4*)PN_SRC(rn) + lane;
#pragma unroll
            for (int q = 0; q < 4; ++q) vn[q] = s4[64 * q]; } }
        if (MODE != 1) {
            const v2u* p2 = (const v2u*)(a.ws + WS_PART) + (size_t)(r - TX) * 256 + lane;
#pragma unroll
            for (int ks = 0; ks < NSPLIT; ++ks)
#pragma unroll
                for (int q = 0; q < 4; ++q) { const v2u u2 = p2[(size_t)ks * 2048 * 256 + 64 * q]; v[q] += (f32x4){bflo(u2.x), bfhi(u2.x), bflo(u2.y), bfhi(u2.y)}; }
        }
#pragma unroll
        for (int q = 0; q < 4; ++q) { if (MODE != 1) ((f32x4*)(X + (size_t)r * D))[lane + 64 * q] = v[q]; ss += (v[q][0] * v[q][0] + v[q][1] * v[q][1]) + (v[q][2] * v[q][2] + v[q][3] * v[q][3]); }
        ss = wave_sum(ss);
        if (lane < 16) RSS[(size_t)r * 16 + lane] = lane == 0 ? ss : 0.f;
        const f32x4* g4 = (const f32x4*)gvec + lane; const f32x4* sc4 = (const f32x4*)(modl + j * 6144 + sci * 1024) + lane;
#pragma unroll
        for (int q = 0; q < 4; ++q) {
            const f32x4 y = (v[q] * g4[64 * q]) * (sc4[64 * q] + 1.f);
            v2u o; o.x = pk2(y[0], y[1]); o.y = pk2(y[2], y[3]);
            *(v2u*)(H + (size_t)r * D + 4 * (lane + 64 * q)) = o;
        }
    }
#undef PN_SRC
}
DI void phase_shw(const Args& a, int G) {
    const int tid = threadIdx.x, lane = tid & 63, wave = tid >> 6, gw = blockIdx.x * 8 + wave, NGW = G * 8;
    const float* MOD = (const float*)(a.ws + WS_MOD); float* SHW = (float*)(a.ws + WS_SHW);
    constexpr int NGRP = (2 * 1280 + 2 * 2048 + 4 * 4096) / 32;
    const int r = lane & 31, h = lane >> 5, j = r;
#pragma unroll 1
    for (int grp = gw; grp < NGRP; grp += NGW) {
        const int it = grp * 32; int l, slot, n0; const bf16* bt;
        if (it < 4 * 4096) { l = it >> 12; slot = 1; n0 = it & 4095; bt = (const bf16*)(a.ws + WS_W1) + ((size_t)l * HIDN + n0) * D; }
        else if (it < 4 * 4096 + 2 * 1280) { const int q = it - 4 * 4096; l = 2 * (q / 1280); slot = 0; n0 = q % 1280; bt = (const bf16*)(a.ws + WS_WIN) + ((size_t)(l >> 1) * INW + n0) * D; }
        else { const int q = it - 4 * 4096 - 2 * 1280; l = 2 * (q >> 11) + 1; slot = 0; n0 = q & 2047; bt = (const bf16*)(a.ws + WS_PW1) + ((size_t)(l >> 1) * 2048 + n0) * D; }
        const bf16* ap = bt + (size_t)r * D + 8 * h;
        const float* sp = MOD + ((size_t)l * 9 + (j < 9 ? j : 0)) * 6144 + (slot ? 3 : 0) * 1024 + 8 * h;
        f32x16 acc;
#pragma unroll
        for (int i = 0; i < 16; ++i) acc[i] = 0.f;
#pragma unroll 8
        for (int s = 0; s < 64; ++s) {
            const bf16x8 av = *(const bf16x8*)(ap + 16 * s);
            v4u bw = {0u, 0u, 0u, 0u};
            if (j < 9) { const f32x4 s0 = *(const f32x4*)(sp + 16 * s), s1 = *(const f32x4*)(sp + 16 * s + 4); bw.x = pk2(s0[0], s0[1]); bw.y = pk2(s0[2], s0[3]); bw.z = pk2(s1[0], s1[1]); bw.w = pk2(s1[2], s1[3]); }
            acc = __builtin_amdgcn_mfma_f32_32x32x16_bf16(av, __builtin_bit_cast(bf16x8, bw), acc, 0, 0, 0);
        }
        if (j < 9) { float* op = SHW + (((size_t)l * 2 + slot) * 9 + j) * 4096 + n0 + 4 * h;
#pragma unroll
            for (int i = 0; i < 16; ++i) op[(i & 3) + 8 * (i >> 2)] = acc[i]; }
    }
}
DI void phase_final(const Args& a, int G) {
    const int tid = threadIdx.x, lane = tid & 63, wave = tid >> 6, gw = blockIdx.x * 8 + wave, NGW = G * 8;
    const float* X = (const float*)(a.ws + WS_X);
    const f32x4* g4 = (const f32x4*)a.in[21] + lane;
    const bool al = (G & 7) == 0;
    const int lw = ((int)blockIdx.x >> 3) * 8 + wave, nlw = (G >> 3) * 8;
    for (int it_ = 0; al ? (lw + it_ * nlw < SEQ) : (gw + it_ * NGW < TX); it_ += 2) {
        const int r = al ? ((int)blockIdx.x & 7) * SEQ + lw + it_ * nlw : gw + it_ * NGW;
        const int r1 = al ? r + nlw : r + NGW; const bool has1 = al ? (lw + (it_ + 1) * nlw < SEQ) : (r1 < TX);
        const f32x4* s0 = (const f32x4*)(X + (size_t)r * D) + lane; const f32x4* s1 = (const f32x4*)(X + (size_t)(has1 ? r1 : r) * D) + lane;
        f32x4 v0[4], v1[4]; float ss0 = 0.f, ss1 = 0.f;
#pragma unroll
        for (int q = 0; q < 4; ++q) { v0[q] = s0[64 * q]; v1[q] = s1[64 * q]; }
#pragma unroll
        for (int q = 0; q < 4; ++q) { ss0 += (v0[q][0] * v0[q][0] + v0[q][1] * v0[q][1]) + (v0[q][2] * v0[q][2] + v0[q][3] * v0[q][3]); ss1 += (v1[q][0] * v1[q][0] + v1[q][1] * v1[q][1]) + (v1[q][2] * v1[q][2] + v1[q][3] * v1[q][3]); }
#pragma unroll
        for (int o = 1; o < 64; o <<= 1) { ss0 += __shfl_xor(ss0, o); ss1 += __shfl_xor(ss1, o); }
        const float rs0 = 1.f / sqrtf(ss0 * (1.f / D) + NORM_EPS), rs1 = 1.f / sqrtf(ss1 * (1.f / D) + NORM_EPS);
#pragma unroll
        for (int q = 0; q < 4; ++q) { ((f32x4*)(a.out + (size_t)r * D))[lane + 64 * q] = v0[q] * rs0 * g4[64 * q]; if (has1) ((f32x4*)(a.out + (size_t)r1 * D))[lane + 64 * q] = v1[q] * rs1 * g4[64 * q]; }
    }
}

DI void phase_pool(const Args& a, int G, int nrows) {
    const int tid = threadIdx.x, lane = tid & 63, wave = tid >> 6, gw = blockIdx.x * 8 + wave, NGW = G * 8;
    const bf16* PX = (const bf16*)(a.ws + WS_PX); bf16* A2 = (bf16*)(a.ws + WS_A2);
    const int g = lane >> 4, half = 1 << g, ch = 8 * lane;
    const bool alp = (G & 7) == 0;
    const int lwp = ((int)blockIdx.x >> 3) * 8 + wave, nlwp = (G >> 3) * 8, nper = nrows == TT ? 288 : 256;
#pragma unroll 1
    for (int cs = alp ? lwp : gw; cs < (alp ? nper : nrows / 8); cs += (alp ? nlwp : NGW)) {
        const int c = alp ? (cs < 256 ? 256 * ((int)blockIdx.x & 7) + cs : TX / 8 + 32 * ((int)blockIdx.x & 7) + (cs - 256)) : cs;
        const int r0 = 8 * c; int seq_lo, Ls; if (r0 < TX) { seq_lo = r0 & ~(SEQ - 1); Ls = SEQ; } else { seq_lo = TX + ((r0 - TX) & ~(CTXL - 1)); Ls = CTXL; }
        const int seq_hi = seq_lo + Ls;
        v4u raw[24];
#pragma unroll
        for (int j = 0; j < 24; ++j) { const int rr = r0 - 8 + j; v4u z = {0u, 0u, 0u, 0u}; if (rr >= seq_lo && rr < seq_hi) z = *(const v4u*)(PX + (size_t)rr * INW + ch); raw[j] = z; }
        float inv[8];
#pragma unroll
        for (int t = 0; t < 8; ++t) { const int r = r0 + t; inv[t] = 1.f / (float)(min(r + half, seq_hi) - max(r - half, seq_lo)); }
        unsigned outw[8][4];
#pragma unroll
        for (int q = 0; q < 4; ++q) {
            f32x2 f[24];
#pragma unroll
            for (int j = 0; j < 24; ++j) { const unsigned u = raw[j][q]; f[j] = (f32x2){bflo(u), bfhi(u)}; }
#pragma unroll
            for (int t = 0; t < 8; ++t) {
                const f32x2 w1 = f[t + 7] + f[t + 8];
                const f32x2 w2 = w1 + (f[t + 6] + f[t + 9]);
                const f32x2 w4 = w2 + ((f[t + 4] + f[t + 5]) + (f[t + 10] + f[t + 11]));
                const f32x2 w8 = w4 + (((f[t] + f[t + 1]) + (f[t + 2] + f[t + 3])) + ((f[t + 12] + f[t + 13]) + (f[t + 14] + f[t + 15])));
                f32x2 w = g == 0 ? w1 : (g == 1 ? w2 : (g == 2 ? w4 : w8));
                w = w * inv[t] - f[t + 8];
                outw[t][q] = pk2(w.x, w.y);
            }
        }
#pragma unroll
        for (int t = 0; t < 8; ++t) { v4u o; o.x = outw[t][0]; o.y = outw[t][1]; o.z = outw[t][2]; o.w = outw[t][3]; *(v4u*)(A2 + (size_t)(r0 + t) * D + ch) = o; }
    }
}

constexpr int AT_KSB = 128 * 144, AT_VROW = 264, AT_BUF = AT_KSB + 64 * AT_VROW;
constexpr int NQB = 1;
DI void attn_unit(LAS unsigned char* lds, const bf16* PX, bf16* A2, const float* sink, int qrow0, int kvh, int hp, int ctxrow0, int xrow0, int nblk  ) {
    const int tid = threadIdx.x, lane = tid & 63, wave = __builtin_amdgcn_readfirstlane(tid >> 6);
    const int g = hp * (2 * NQB) + wave / (4 / NQB), qoff = (wave % (4 / NQB)) * 32 * NQB, hq = 4 * kvh + g, r = lane & 31, h = lane >> 5;
    const int nch = nblk < 0 ? 2 : 3 + (nblk > 0) + (nblk < 15);
    bf16x8 qf[NQB][4];
#pragma unroll
    for (int qb = 0; qb < NQB; ++qb)
#pragma unroll
        for (int ks = 0; ks < 4; ++ks) qf[qb][ks] = *(const bf16x8*)(PX + (size_t)(qrow0 + qoff + 32 * qb + r) * INW + 512 + 64 * hq + 16 * ks + 8 * h);
    float mrun[NQB], lrun[NQB]; f32x16 O[NQB][2];
    const float sk = sink[hq] * LOG2E;
#pragma unroll
    for (int qb = 0; qb < NQB; ++qb) { mrun[qb] = sk; lrun[qb] = h == 0 ? 1.f : 0.f;
#pragma unroll
        for (int db = 0; db < 2; ++db)
#pragma unroll
            for (int i = 0; i < 16; ++i) O[qb][db][i] = 0.f; }
    v4u kreg[2], vreg[2];
#define AT_ROW(ci) ((ci) < 2 ? ctxrow0 + 128 * (ci) : xrow0 + 128 * (nblk - 1 + ((ci) - 2) + (nblk == 0 ? 1 : 0)))
#define AT_ISSUE(ci) do { const int row_ = AT_ROW(ci); _Pragma("unroll") for (int i_ = 0; i_ < 2; ++i_) { const int p_ = tid + 512 * i_; \
        kreg[i_] = *(const v4u*)(PX + (size_t)(row_ + (p_ >> 3)) * INW + 1024 + 64 * kvh + 8 * (p_ & 7)); \
        vreg[i_] = *(const v4u*)(PX + (size_t)(row_ + (p_ & 127)) * INW + 1152 + 64 * kvh + 8 * (p_ >> 7)); } } while (0)
#define AT_COMMIT(buf) do { LAS unsigned char* b_ = lds + (buf) * AT_BUF; _Pragma("unroll") for (int i_ = 0; i_ < 2; ++i_) { const int p_ = tid + 512 * i_; \
        *(LAS v4u*)(b_ + (p_ >> 3) * 144 + (p_ & 7) * 16) = kreg[i_]; \
        LAS unsigned short* vt_ = (LAS unsigned short*)(b_ + AT_KSB + (8 * (p_ >> 7)) * AT_VROW + (p_ & 127) * 2); const v4u v_ = vreg[i_]; \
        vt_[0] = (unsigned short)v_.x; vt_[AT_VROW / 2] = (unsigned short)(v_.x >> 16); vt_[2 * (AT_VROW / 2)] = (unsigned short)v_.y; vt_[3 * (AT_VROW / 2)] = (unsigned short)(v_.y >> 16); \
        vt_[4 * (AT_VROW / 2)] = (unsigned short)v_.z; vt_[5 * (AT_VROW / 2)] = (unsigned short)(v_.z >> 16); vt_[6 * (AT_VROW / 2)] = (unsigned short)v_.w; vt_[7 * (AT_VROW / 2)] = (unsigned short)(v_.w >> 16); } } while (0)
    AT_ISSUE(0); AT_COMMIT(0); __syncthreads();
#pragma unroll 1
    for (int ci = 0; ci < nch; ++ci) {
        if (ci + 1 < nch) AT_ISSUE(ci + 1);
        int mt = 0; if (ci >= 2) mt = ((ci - 2) + (nblk == 0 ? 1 : 0)) - 1;
        const LAS unsigned char* Kb = lds + (ci & 1) * AT_BUF; const LAS unsigned char* Vb = Kb + AT_KSB;
#pragma unroll 1
        for (int kp = 0; kp < 2; ++kp) {
            static_assert(NQB == 1, "the paired-tile loop is written for one 32-row query block per wave");
            const int qi0 = qoff;
            const bool need = mt == 0 || (mt < 0 ? (64 * kp + 63 >= qi0) : (64 * kp <= qi0 + 31));
            if (!need) continue;
            bf16x8 kf0[4], kf1[4];
#pragma unroll
            for (int ks = 0; ks < 4; ++ks) { kf0[ks] = *(const LAS bf16x8*)(Kb + (64 * kp + r) * 144 + 32 * ks + 16 * h); kf1[ks] = *(const LAS bf16x8*)(Kb + (64 * kp + 32 + r) * 144 + 32 * ks + 16 * h); }
            f32x16 S0, S1;
#pragma unroll
            for (int i = 0; i < 16; ++i) { S0[i] = 0.f; S1[i] = 0.f; }
#pragma unroll
            for (int ks = 0; ks < 4; ++ks) { S0 = __builtin_amdgcn_mfma_f32_32x32x16_bf16(kf0[ks], qf[0][ks], S0, 0, 0, 0); S1 = __builtin_amdgcn_mfma_f32_32x32x16_bf16(kf1[ks], qf[0][ks], S1, 0, 0, 0); }
            bf16x8 vf[2][4];
#pragma unroll
            for (int db = 0; db < 2; ++db)
#pragma unroll
                for (int s = 0; s < 4; ++s) { const LAS unsigned char* vp = Vb + (32 * db + r) * AT_VROW + (64 * kp + 16 * s + 4 * h) * 2;
                    const s16x4 lo = *(const LAS s16x4*)vp, hi = *(const LAS s16x4*)(vp + 16); vf[db][s] = __builtin_shufflevector(lo, hi, 0, 1, 2, 3, 4, 5, 6, 7); }
            if (mt != 0) { const int dq = (qi0 + r - 64 * kp - 4 * h) * mt;
#pragma unroll
                for (int i = 0; i < 16; ++i) { const int d0 = dq - ((i & 3) + 8 * (i >> 2)) * mt, d1 = d0 - 32 * mt; S0[i] = d0 >= 0 ? S0[i] : -1e30f; S1[i] = d1 >= 0 ? S1[i] : -1e30f; } }
            float mx = fmaxf(S0[0], S1[0]);
#pragma unroll
            for (int i = 1; i < 16; ++i) mx = fmaxf(mx, fmaxf(S0[i], S1[i]));
            mx = fmaxf(mx, __shfl_xor(mx, 32));
            const float mn = fmaxf(mrun[0], mx);
            if (__builtin_amdgcn_ballot_w64(mn != mrun[0]) != 0ull) {
                const float alpha = __builtin_amdgcn_exp2f(mrun[0] - mn); mrun[0] = mn; lrun[0] *= alpha;
#pragma unroll
                for (int db = 0; db < 2; ++db)
#pragma unroll
                    for (int i = 0; i < 16; ++i) O[0][db][i] *= alpha;
            }
            float ps0 = 0.f, ps1 = 0.f;
#pragma unroll
            for (int i = 0; i < 16; ++i) { S0[i] = __builtin_amdgcn_exp2f(S0[i] - mn); S1[i] = __builtin_amdgcn_exp2f(S1[i] - mn); ps0 += S0[i]; ps1 += S1[i]; }
            lrun[0] += ps0 + ps1;
            bf16x8 pf[4];
#pragma unroll
            for (int s = 0; s < 2; ++s) { v4u p; p.x = pk2(S0[8 * s], S0[8 * s + 1]); p.y = pk2(S0[8 * s + 2], S0[8 * s + 3]); p.z = pk2(S0[8 * s + 4], S0[8 * s + 5]); p.w = pk2(S0[8 * s + 6], S0[8 * s + 7]); pf[s] = __builtin_bit_cast(bf16x8, p);
                v4u q; q.x = pk2(S1[8 * s], S1[8 * s + 1]); q.y = pk2(S1[8 * s + 2], S1[8 * s + 3]); q.z = pk2(S1[8 * s + 4], S1[8 * s + 5]); q.w = pk2(S1[8 * s + 6], S1[8 * s + 7]); pf[2 + s] = __builtin_bit_cast(bf16x8, q); }
#pragma unroll
            for (int s = 0; s < 4; ++s)
#pragma unroll
                for (int db = 0; db < 2; ++db) O[0][db] = __builtin_amdgcn_mfma_f32_32x32x16_bf16(vf[db][s], pf[s], O[0][db], 0, 0, 0);
        }
        if (ci + 1 < nch) AT_COMMIT((ci + 1) & 1);
        __syncthreads();
    }
#pragma unroll
    for (int qb = 0; qb < NQB; ++qb) {
        const float lt = lrun[qb] + __shfl_xor(lrun[qb], 32), inv = 1.f / lt;
        bf16* orow = A2 + (size_t)(qrow0 + qoff + 32 * qb + r) * D + 512 + 64 * hq;
#pragma unroll
        for (int db = 0; db < 2; ++db)
#pragma unroll
            for (int gq = 0; gq < 4; ++gq) { v2u o; o.x = pk2(O[qb][db][4 * gq] * inv, O[qb][db][4 * gq + 1] * inv); o.y = pk2(O[qb][db][4 * gq + 2] * inv, O[qb][db][4 * gq + 3] * inv);
                *(v2u*)(orow + 32 * db + 8 * gq + 4 * h) = o; }
    }
#undef AT_ROW
#undef AT_ISSUE
#undef AT_COMMIT
}
DI void phase_attn(const Args& a, LAS unsigned char* lds, int G, int layer_i, bool with_ctx) {
    const bf16* PX = (const bf16*)(a.ws + WS_PX); bf16* A2 = (bf16*)(a.ws + WS_A2);
    const float* sink = a.in[11] + layer_i * 8;
    constexpr int UPB = 2 / NQB;
    const int nunits = (256 + (with_ctx ? 32 : 0)) * UPB;
    if (NQB == 1 && (G & 7) == 0) {
        const int b = blockIdx.x & 7, per = 64 + (with_ctx ? 8 : 0);
        for (int hl = blockIdx.x >> 3; hl < per; hl += G >> 3) {
            if (hl < 64) { const int kvh = hl >> 5, n = (hl >> 1) & 15, hp = hl & 1; attn_unit(lds, PX, A2, sink, b * SEQ + 128 * n, kvh, hp, TX + b * CTXL, b * SEQ, n); }
            else { const int hc = hl - 64, kvh = hc >> 2, cn = (hc >> 1) & 1, hp = hc & 1; attn_unit(lds, PX, A2, sink, TX + b * CTXL + 128 * cn, kvh, hp, TX + b * CTXL, 0, -1); }
        }
        return;
    }
    for (int uu = blockIdx.x; uu < nunits; uu += G) {
        const int u = uu / UPB, hp = uu % UPB;
        if (u < 256) { const int b = u >> 5, kvh = (u >> 4) & 1, n = u & 15; attn_unit(lds, PX, A2, sink, b * SEQ + 128 * n, kvh, hp, TX + b * CTXL, b * SEQ, n); }
        else { const int v = u - 256, b = v >> 2, kvh = (v >> 1) & 1, cn = v & 1; attn_unit(lds, PX, A2, sink, TX + b * CTXL + 128 * cn, kvh, hp, TX + b * CTXL, 0, -1); }
    }
}

constexpr int CT = 16;
DI void phase_conv(const Args& a, LAS unsigned char* lds, int G, int li, int nrows) {
    const int tid = threadIdx.x, ch = 2 * tid;
    const bf16* Gb = (const bf16*)(a.ws + WS_PX); bf16* Y = (bf16*)(a.ws + WS_A2);
    f32x2 wv[31];
#pragma unroll
    for (int k = 0; k < 31; ++k) wv[k] = *(const f32x2*)(a.in[14] + ((size_t)li * 31 + k) * D + ch);
    const f32x2 bias = *(const f32x2*)(a.in[15] + li * D + ch), lg = *(const f32x2*)(a.in[16] + li * D + ch), lb = *(const f32x2*)(a.in[17] + li * D + ch);
    LAS f32x2* red = (LAS f32x2*)lds;
    LAS f32x2* stats = (LAS f32x2*)(lds + 131072);
    const int ntiles = nrows / CT;
    const bool alc = (G & 7) == 0;
    const int npc = nrows == TT ? 144 : 128;
#pragma unroll 1
    for (int slot = alc ? ((int)blockIdx.x >> 3) : (int)blockIdx.x; slot < (alc ? npc : ntiles); slot += (alc ? (G >> 3) : G)) {
        const int tile = alc ? (slot < 128 ? 128 * ((int)blockIdx.x & 7) + slot : TX / CT + 16 * ((int)blockIdx.x & 7) + (slot - 128)) : slot;
        const int r0 = tile * CT;
        int lo, hi; if (r0 < TX) { lo = r0 & ~(SEQ - 1); hi = lo + SEQ; } else { lo = TX + ((r0 - TX) & ~(CTXL - 1)); hi = lo + CTXL; }
        f32x2 v[CT + 30];
#pragma unroll
        for (int j = 0; j < CT + 30; ++j) { const int rr = r0 - 15 + j; unsigned u = 0u; if (rr >= lo && rr < hi) u = *(const unsigned*)(Gb + (size_t)rr * D + ch); v[j].x = bflo(u); v[j].y = bfhi(u); }
        f32x2 acc[CT];
#pragma unroll
        for (int t = 0; t < CT; ++t) { acc[t] = bias;
#pragma unroll
            for (int k = 0; k < 31; ++k) acc[t] += wv[k] * v[t + k]; }
#pragma unroll
        for (int t = 0; t < CT; ++t) { f32x2 sq; sq.x = acc[t].x + acc[t].y; sq.y = acc[t].x * acc[t].x + acc[t].y * acc[t].y; red[t * 512 + tid] = sq; }
        __syncthreads();
        { const int t = tid >> 5, p = tid & 31; f32x2 s = {0.f, 0.f};
#pragma unroll
            for (int e = 0; e < 16; ++e) s += red[t * 512 + p + 32 * e];
#pragma unroll
            for (int o = 1; o < 32; o <<= 1) { s.x += __shfl_xor(s.x, o); s.y += __shfl_xor(s.y, o); }
            if (p == 0) { const float mean = s.x * (1.f / D), var = fmaxf(s.y * (1.f / D) - mean * mean, 0.f); f32x2 st; st.x = mean; st.y = 1.f / sqrtf(var + NORM_EPS); stats[t] = st; } }
        __syncthreads();
#pragma unroll
        for (int t = 0; t < CT; ++t) { const f32x2 st = stats[t]; f32x2 y = (acc[t] - st.x) * st.y * lg + lb;
            y.x = y.x * __builtin_amdgcn_rcpf(1.f + __expf(-y.x)); y.y = y.y * __builtin_amdgcn_rcpf(1.f + __expf(-y.y));
            *(unsigned*)(Y + (size_t)(r0 + t) * D + ch) = pk2(y.x, y.y); }
    }
}

struct OrderX : pg8::StaticOrder {
    int nextra;
    __device__ __forceinline__ bool next(int i, pg8::Unit& u) const {
        const long Lx = (long)i * G + c; const bool inmain = Lx < nwg;
        pg8::Unit m; m.pm = 0; m.pn = 0; m.kb = 0; m.nt = ntf;
        if (inmain) pg8::StaticOrder::next(i, m);
        const int e = (int)(Lx - nwg);
        u.pm = inmain ? m.pm : 64 + e; u.pn = inmain ? m.pn : 4; u.kb = 0; u.nt = ntf;
        return inmain || e < nextra; }
};
struct OrderBatch : pg8::StaticOrder {
    __device__ __forceinline__ bool next(int i, pg8::Unit& u) const {
        const int xcd = c & 7, rank = c >> 3, Gx = (G - xcd + 7) >> 3, lid = i * Gx + rank, pn = lid / 9, prow = lid - 9 * pn;
        u.pm = prow < 8 ? 8 * xcd + prow : 64 + xcd; u.pn = pn; u.kb = 0; u.nt = ntf;
        return lid < 9 * nN; }
};
struct OrderSplit : pg8::StaticOrder {
    int nsplit;
    __device__ __forceinline__ bool next(int i, pg8::Unit& u) const {
        const long Lx = (long)i * G + c; const bool inmain = Lx < nwg;
        pg8::Unit m; m.pm = 0; m.pn = 0; m.kb = 0; m.nt = ntf;
        if (inmain) pg8::StaticOrder::next(i, m);
        const int e = (int)(Lx - nwg), ns = nsplit > 0 ? nsplit : 1, q_ = e >> 3, t = ((e & 7) << 2) | (q_ & 3), ks = q_ >> 2, nts = ntf / ns;
        u.pm = inmain ? m.pm : 64 + (t >> 2); u.pn = inmain ? m.pn : (t & 3); u.nt = inmain ? ntf : nts; u.kb = inmain ? 0 : ks * nts * 128;
        return inmain || e < 32 * nsplit; }
};

#define XB_TMO      128
#define XB_XCNT(j)  (256  + 64 * (j))
#define XB_XSUB(j)  (1280 + 64 * (j))
#define XB_XGEN(j)  (2304 + 64 * (j))
#define XB_TOP      3328
#define XB_TOPGEN   3392
#define XCD_BAR_WORDS 3456
#define XB_SPIN_CAP (1u << 18)

__device__ __forceinline__ unsigned xb_ld(unsigned* p)              { return __hip_atomic_load(p, __ATOMIC_RELAXED, __HIP_MEMORY_SCOPE_AGENT); }
__device__ __forceinline__ unsigned xb_add(unsigned* p, unsigned v) { return __hip_atomic_fetch_add(p, v, __ATOMIC_RELAXED, __HIP_MEMORY_SCOPE_AGENT); }
__device__ __forceinline__ unsigned xb_xcc_id() { return (unsigned)__builtin_amdgcn_s_getreg((3 << 11) | 20) & 0xFu; }
#define XB_SPIN(cond, bar) do { unsigned _sp = 0; while (cond) { __builtin_amdgcn_s_sleep(1); \
    if ((++_sp & 255u) == 0u) { if (xb_ld(&(bar)[XB_TMO])) break; if (_sp > XB_SPIN_CAP) { atomicAdd(&(bar)[XB_TMO], 1u); break; } } } } while (0)

struct XcdBarrier {
    unsigned* bar; unsigned x;
    volatile LAS unsigned* st;
};

__device__ __forceinline__ XcdBarrier xcd_barrier_post(unsigned* bar, volatile LAS unsigned* st) {
    XcdBarrier b; b.bar = bar; b.x = xb_xcc_id(); b.st = st;
    if (threadIdx.x == 0) (void)xb_add(&bar[XB_XCNT(b.x)], 1u);
    return b;
}
__device__ __forceinline__ void xcd_barrier_complete(unsigned* bar, unsigned x, unsigned& nloc, unsigned& nx) {
    const unsigned G = gridDim.x * gridDim.y * gridDim.z;
    unsigned sum, cnt, mine, sp = 0u;
    for (;;) {
        sum = 0u; cnt = 0u; mine = 0u;
#pragma unroll
        for (unsigned j = 0; j < 16; ++j) { const unsigned c = xb_ld(&bar[XB_XCNT(j)]); sum += c; cnt += (c > 0u) ? 1u : 0u; mine = (j == x) ? c : mine; }
        if (sum == G) break;
        __builtin_amdgcn_s_sleep(1);
        if ((++sp & 255u) == 0u) { if (xb_ld(&bar[XB_TMO])) break; if (sp > XB_SPIN_CAP) { atomicAdd(&bar[XB_TMO], 1u); break; } }
    }
    nloc = mine > 0u ? mine : 1u; nx = cnt > 0u ? cnt : 1u;
}

__device__ __forceinline__ void xcd_barrier(const XcdBarrier& b, bool wb = true) {
    asm volatile("s_waitcnt vmcnt(0)" ::: "memory");
    __syncthreads();
    if (threadIdx.x == 0) {
        unsigned* bar = b.bar;
        __builtin_amdgcn_s_waitcnt(0);
        unsigned nloc = b.st[0], nx = b.st[1];
        if (nloc == 0u) { xcd_barrier_complete(bar, b.x, nloc, nx); b.st[0] = nloc; b.st[1] = nx; }
        const unsigned old = xb_add(&bar[XB_XSUB(b.x)], 1u);
        const unsigned gen = old / nloc;
        if (old + 1u == (gen + 1u) * nloc) {
            if (wb) __builtin_amdgcn_fence(__ATOMIC_RELEASE, "agent");
            asm volatile("s_waitcnt vmcnt(0)" ::: "memory");
            if (wb) {
            const unsigned og = xb_add(&bar[XB_TOP], 1u);
            const unsigned tg = og / nx;
            if (og + 1u == (tg + 1u) * nx) xb_add(&bar[XB_TOPGEN], 1u);
            else XB_SPIN(xb_ld(&bar[XB_TOPGEN]) == tg, bar);
            }
            __builtin_amdgcn_fence(__ATOMIC_ACQUIRE, "agent");
            xb_add(&bar[XB_XGEN(b.x)], 1u);
            asm volatile("s_waitcnt vmcnt(0)" ::: "memory");
        } else {
            XB_SPIN(xb_ld(&bar[XB_XGEN(b.x)]) == gen, bar);
            __builtin_amdgcn_fence(__ATOMIC_ACQUIRE, "agent");
            asm volatile("s_waitcnt vmcnt(0)" ::: "memory");
        }
    }
    __syncthreads();
}
#define IN(k) (lo <= (k) && (k) < hi)
#ifndef REP_SYNC
#define REP_SYNC 1
#endif
#ifndef REP_W1
#define REP_W1 1
#endif
#ifndef REP_RES
#define REP_RES 1
#endif
#ifndef REP_ATTN
#define REP_ATTN 1
#endif
#ifndef REP_POOL
#define REP_POOL 1
#endif
#ifndef REP_CONV
#define REP_CONV 1
#endif
#ifndef REP_NORM
#define REP_NORM 1
#endif
#ifndef REP_PREP
#define REP_PREP 1
#endif
#define SEAM(k) do { if (IN(k) && IN((k) + 1)) { for (int r_ = 0; r_ < REP_SYNC; ++r_) { xcd_barrier(xb); } } } while (0)
#define SEAM_L(k) do { if (IN(k) && IN((k) + 1)) xcd_barrier(xb, !regular); } while (0)
#define SEAM_X(k) SEAM_L(k)
template <int l> DI void layer_fwd(const Args& a, LAS unsigned char* lds, cg::grid_group& grid, const XcdBarrier& xb, int G, int lo, int hi, bool regular) {
    unsigned char* ws = a.ws;
    float* X = (float*)(ws + WS_X); bf16* H = (bf16*)(ws + WS_H); bf16* PX = (bf16*)(ws + WS_PX); bf16* A2 = (bf16*)(ws + WS_A2); bf16* HB = (bf16*)(ws + WS_HID);
    const float* MOD = (const float*)(ws + WS_MOD); float* RSS = (float*)(ws + WS_RSS); const float* SHW = (const float*)(ws + WS_SHW); float* PART = (float*)(ws + WS_PART);
    constexpr int p0 = 1 + 7 * l, li = l >> 1;
    const float* modl = MOD + (size_t)l * 9 * 6144;
    constexpr int Mrows = l < 2 ? TT : TX;
    const pg8::RowScale R0{RSS, SHW + (size_t)(l * 2 + 0) * 9 * 4096}, R1{RSS, SHW + (size_t)(l * 2 + 1) * 9 * 4096};
    if (l <= 2) {
        if (IN(p0)) { if (l == 0) { for (int pr_ = 0; pr_ < P_L0N; ++pr_) phase_norm<1, 0>(a, G, 0, TT, a.in[6], modl, 1); for (int pr_ = 0; pr_ < P_SHW; ++pr_) phase_shw(a, G); } else phase_norm<0, 8>(a, G, TX, TT, a.in[6] + l * D, modl, 1); }
        SEAM(p0);
    }
    if ((l & 1) == 0) {
        if (IN(p0 + 1)) { pg8::Gemm g{H, (const bf16*)(ws + WS_WIN) + (size_t)li * INW * D, l == 0 ? TT : TX, INW, D};
            if constexpr (l == 0) { OrderBatch S; S.init(g.M, INW, G, (int)blockIdx.x, D);
                pg8::EpiPX E{PX, (const float*)(ws + WS_TAB), 0.125f * LOG2E, R0};
                pg8::gemm_phase<pg8::EpiPX, OrderBatch, true, true>(lds, g, S, E); }
            else { OrderX S; S.init(g.M, INW, G, (int)blockIdx.x, D); S.nextra = 8;
                pg8::EpiPX E{PX, (const float*)(ws + WS_TAB), 0.125f * LOG2E, R0};
                pg8::gemm_phase<pg8::EpiPX, OrderX, true, true>(lds, g, S, E); } }
        SEAM_X(p0 + 1);
        if (IN(p0 + 2)) {
            for (int r_ = 0; r_ < REP_ATTN; ++r_) phase_attn(a, lds, G, li, l == 0);
            for (int r_ = 0; r_ < REP_POOL; ++r_) phase_pool(a, G, Mrows); }
        SEAM_X(p0 + 2);
        if (IN(p0 + 3)) { pg8::Gemm g{A2, (const bf16*)(ws + WS_WOUT) + (size_t)li * D * D, Mrows, D, D};
            OrderSplit S; S.init(TX, D, G, (int)blockIdx.x, D); S.nsplit = l < 2 ? 4 : 0;
            pg8::EpiRes<true> E{X, modl, 2 * 1024, D / 64, PART, a.in[7] + l * D, modl + 4 * 1024, H, RSS, l == 0 ? a.in[0] : (const float*)X};
#if REP_RES > 1
            { pg8::EpiRes<true> E0{X, (const float*)(ws + WS_ZERO), 0, D / 64, PART, a.in[7] + l * D, modl + 4 * 1024, H, RSS}; pg8::gemm_phase<pg8::EpiRes<true>, OrderSplit, true, true>(lds, g, S, E0); }
#endif
            pg8::gemm_phase<pg8::EpiRes<true>, OrderSplit, true, true>(lds, g, S, E); }
        if (l < 2) SEAM_L(p0 + 3); else SEAM(p0 + 3);
    } else {
        if (IN(p0 + 1)) { pg8::Gemm g{H, (const bf16*)(ws + WS_PW1) + (size_t)li * 2048 * D, Mrows, 2048, D};
            if constexpr (l == 1) { OrderBatch S; S.init(Mrows, 2048, G, (int)blockIdx.x, D);
            pg8::EpiGLU E{PX, R0};
                pg8::gemm_phase<pg8::EpiGLU, OrderBatch, true, true>(lds, g, S, E); }
            else { pg8::StaticOrder S; S.init(Mrows, 2048, G, (int)blockIdx.x, D);
            pg8::EpiGLU E{PX, R0};
                pg8::gemm_phase<pg8::EpiGLU, pg8::StaticOrder, true, true>(lds, g, S, E); } }
        SEAM_X(p0 + 1);
        if (IN(p0 + 2)) { for (int r_ = 0; r_ < REP_CONV; ++r_) { phase_conv(a, lds, G, li, Mrows); __syncthreads(); } }
        SEAM_X(p0 + 2);
        if (IN(p0 + 3)) { pg8::Gemm g{A2, (const bf16*)(ws + WS_PW2) + (size_t)li * D * D, Mrows, D, D};
            OrderSplit S; S.init(TX, D, G, (int)blockIdx.x, D); S.nsplit = l < 2 ? 4 : 0;
            pg8::EpiRes<true> E{X, modl, 2 * 1024, D / 64, PART, a.in[7] + l * D, modl + 4 * 1024, H, RSS, l == 0 ? a.in[0] : (const float*)X};
#if REP_RES > 1
            { pg8::EpiRes<true> E0{X, (const float*)(ws + WS_ZERO), 0, D / 64, PART, a.in[7] + l * D, modl + 4 * 1024, H, RSS}; pg8::gemm_phase<pg8::EpiRes<true>, OrderSplit, true, true>(lds, g, S, E0); }
#endif
            pg8::gemm_phase<pg8::EpiRes<true>, OrderSplit, true, true>(lds, g, S, E); }
        if (l < 2) SEAM_L(p0 + 3); else SEAM(p0 + 3);
    }
    if (l < 2) {
        if (IN(p0 + 4)) phase_norm<(l == 0 ? 2 : 0), 4>(a, G, TX, TT, a.in[7] + l * D, modl, 4);
        SEAM(p0 + 4);
    }
    if (IN(p0 + 5)) { pg8::Gemm g{H, (const bf16*)(ws + WS_W1) + (size_t)l * D * HIDN, Mrows, HIDN, D};
        if constexpr (l < 2) { OrderBatch S; S.init(Mrows, HIDN, G, (int)blockIdx.x, D);
        pg8::EpiSq E{HB, R1};
            pg8::gemm_phase<pg8::EpiSq, OrderBatch, true, true>(lds, g, S, E); }
        else { pg8::StaticOrder S; S.init(Mrows, HIDN, G, (int)blockIdx.x, D);
        pg8::EpiSq E{HB, R1};
            pg8::gemm_phase<pg8::EpiSq, pg8::StaticOrder, true, true>(lds, g, S, E); }
        }
    SEAM_X(p0 + 5);
    if (IN(p0 + 6)) { pg8::Gemm g{HB, (const bf16*)(ws + WS_W2) + (size_t)l * D * HIDN, Mrows, D, HIDN};
        OrderSplit S; S.init(TX, D, G, (int)blockIdx.x, HIDN); S.nsplit = l < 2 ? 8 : 0;
        constexpr int ln = l < 3 ? l + 1 : 3;
        pg8::EpiRes<(l < 3)> E{X, modl, 5 * 1024, HIDN / 64, PART, a.in[6] + ln * D, MOD + (size_t)ln * 9 * 6144 + 1 * 1024, H, RSS, X};
#if REP_RES > 1
        { pg8::EpiRes<(l < 3)> E0{X, (const float*)(ws + WS_ZERO), 0, HIDN / 64, PART, a.in[6] + ln * D, MOD + (size_t)ln * 9 * 6144 + 1 * 1024, H, RSS}; pg8::gemm_phase<pg8::EpiRes<(l < 3)>, OrderSplit, true, true>(lds, g, S, E0); }
#endif
        pg8::gemm_phase<pg8::EpiRes<(l < 3)>, OrderSplit, true, true>(lds, g, S, E); }
    if (l == 2) SEAM(p0 + 6); else SEAM_L(p0 + 6);
}
__global__ void __launch_bounds__(512, 2) mega_fwd(Args a) {
    extern __shared__ __attribute__((aligned(16))) unsigned char lds_raw[];
    LAS unsigned char* lds = (LAS unsigned char*)lds_raw;
    const int G = gridDim.x, lo = a.ph_lo, hi = a.ph_hi;
    cg::grid_group grid = cg::this_grid();
    volatile LAS unsigned* xst = (volatile LAS unsigned*)(lds + LDS_BYTES - 64);
    if (threadIdx.x == 0) { xst[0] = 0u; xst[1] = 0u; }
    __syncthreads();
    XcdBarrier xb = xcd_barrier_post((unsigned*)(a.ws + WS_BAR), xst);
    unsigned* xid = (unsigned*)(a.ws + WS_ZERO);
    if (threadIdx.x == 0) xid[blockIdx.x] = xb.x;
    if (a.ph_hi < 0) grid.sync();
    unsigned char* ws = a.ws;
    float* X = (float*)(ws + WS_X); bf16* H = (bf16*)(ws + WS_H); bf16* PX = (bf16*)(ws + WS_PX); bf16* A2 = (bf16*)(ws + WS_A2); bf16* HB = (bf16*)(ws + WS_HID);
    const float* MOD = (const float*)(ws + WS_MOD);
    if (IN(0)) { for (int r_ = 0; r_ < REP_PREP; ++r_) { phase_prep(a, lds, G); __syncthreads(); } }
    SEAM(0);
    bool regular = false;
    if (IN(0) && IN(1)) {
        int ok = ((G & 7) == 0) ? 1 : 0;
        for (int t = threadIdx.x; t < G; t += 512) ok &= (xid[t] == xid[t & 7]) ? 1 : 0;
        if (threadIdx.x < 8) for (int k = 0; k < (int)threadIdx.x; ++k) ok &= (xid[threadIdx.x] != xid[k]) ? 1 : 0;
        regular = __syncthreads_and(ok) != 0;
    }
    layer_fwd<0>(a, lds, grid, xb, G, lo, hi, regular); layer_fwd<1>(a, lds, grid, xb, G, lo, hi, regular); layer_fwd<2>(a, lds, grid, xb, G, lo, hi, regular); layer_fwd<3>(a, lds, grid, xb, G, lo, hi, regular);
    if (IN(29)) { for (int pr_ = 0; pr_ < P_FIN; ++pr_) phase_final(a, G); }
#undef IN
#undef SEAM
}

extern "C" void kernel_launch(void* const* d_in, const int* in_sizes, int n_in, void* d_out, int out_size, void* d_ws, size_t ws_size, hipStream_t stream) {
    static int grid = 0;
    if (grid == 0) {
        if (n_in != 22 || in_sizes[0] != TX * D || out_size != TX * D || ws_size < WS_END) { fprintf(stderr, "kernel_launch: unexpected shapes (n_in %d, in0 %d, out %d, ws %zu)\n", n_in, n_in > 0 ? in_sizes[0] : -1, out_size, ws_size); grid = -1; return; }
        int dev = 0, cus = 0, per_cu = 0;
        if (hipGetDevice(&dev) != hipSuccess || hipDeviceGetAttribute(&cus, hipDeviceAttributeMultiprocessorCount, dev) != hipSuccess) { grid = -1; return; }
        if (hipFuncSetAttribute((const void*)mega_fwd, hipFuncAttributeMaxDynamicSharedMemorySize, LDS_BYTES) != hipSuccess) { fprintf(stderr, "kernel_launch: hipFuncSetAttribute failed\n"); grid = -1; return; }
        if (hipOccupancyMaxActiveBlocksPerMultiprocessor(&per_cu, (const void*)mega_fwd, 512, LDS_BYTES) != hipSuccess || per_cu < 1) { fprintf(stderr, "kernel_launch: occupancy query says %d blocks per CU\n", per_cu); (void)hipGetLastError(); per_cu = 1; }
        grid = cus * 1;
    }
    if (grid < 0) return;
    Args a{};
    for (int i = 0; i < 22; ++i) a.in[i] = (const float*)d_in[i];
    a.out = (float*)d_out; a.ws = (unsigned char*)d_ws;
#if MK_COOP
    if (hipMemsetAsync((char*)d_ws + WS_BAR, 0, BAR_BYTES + (REP_RES > 1 ? 9 * 6144 * 4 : 0), stream) != hipSuccess) { fprintf(stderr, "kernel_launch: memset failed\n"); return; }
    a.ph_lo = 0; a.ph_hi = NPHASE;
    void* args[] = {&a};
    hipError_t e = hipLaunchCooperativeKernel((const void*)mega_fwd, dim3(grid), dim3(512), args, LDS_BYTES, stream);
    if (e != hipSuccess) fprintf(stderr, "kernel_launch: cooperative launch failed: %s (grid %d)\n", hipGetErrorString(e), grid);
#else
    for (int p = 0; p < NPHASE; ++p) { a.ph_lo = p; a.ph_hi = p + 1; hipLaunchKernelGGL(mega_fwd, dim3(grid), dim3(512), LDS_BYTES, stream, a); }
#endif
}
```
